# Optimizing an MI355X kernel written in HIP

```python
import math
import jax, jax.numpy as jnp
from jax import lax
import numpy as np

D_MODEL = 1024
BATCH = 8
SEQ = 4096
DEPTH = 4

N_MIXERS = 3
BLOCK = 128
RMS_EPS = 1e-6

SWA_HEADS = 16
SWA_KV_HEADS = 2
SWA_HEAD_DIM = 64
SWA_WINDOW = 128

REL_BUCKETS = 32
REL_MAX_DIST = 128

SB_HEADS = 16
SB_HEAD_DIM = 64

MLA_HEADS = 16
MLA_NOPE_DIM = 64
MLA_ROPE_DIM = 32
MLA_V_DIM = 64
MLA_Q_RANK = 384
MLA_KV_RANK = 256
ROPE_THETA = 10000.0

FFN_DIM = 2816
N_EXPERTS = 8
TOP_K = 2
EXPERT_DIM = 3584

kernel_name = 'hybrid_swa_stickbreak_mla_moe_trunk'


def rms_norm(x, g):
    xf = x.astype(jnp.float32)
    y = xf * lax.rsqrt(jnp.mean(xf * xf, axis=-1, keepdims=True) + RMS_EPS)
    return (y * g.astype(jnp.float32)).astype(x.dtype)


def t5_causal_bucket(dist):
    max_exact = REL_BUCKETS // 2
    d = jnp.maximum(dist, 1).astype(jnp.float32)
    large = max_exact + (jnp.log(d / max_exact) / math.log(REL_MAX_DIST / max_exact)
                         * (REL_BUCKETS - max_exact)).astype(jnp.int32)
    large = jnp.minimum(large, REL_BUCKETS - 1)
    return jnp.where(dist < max_exact, dist, large)


def rope_tables(seq, dim):
    inv = ROPE_THETA ** (-jnp.arange(0, dim, 2, dtype=jnp.float32) / dim)
    ang = jnp.arange(seq, dtype=jnp.float32)[:, None] * inv[None, :]
    return jnp.cos(ang), jnp.sin(ang)


def apply_rope(x, cos, sin):
    x1, x2 = jnp.split(x, 2, axis=-1)
    c = cos[None, :, None, :].astype(x.dtype)
    s = sin[None, :, None, :].astype(x.dtype)
    return jnp.concatenate([x1 * c - x2 * s, x1 * s + x2 * c], axis=-1)


def swa_sink_attention(h, w_qkv, b_qkv, sinks, w_o, rel_bias):
    B, S, _ = h.shape
    nb = S // BLOCK
    G = SWA_HEADS // SWA_KV_HEADS
    qkv = h @ w_qkv + b_qkv
    q, k, v = jnp.split(qkv, [SWA_HEADS * SWA_HEAD_DIM,
                              (SWA_HEADS + SWA_KV_HEADS) * SWA_HEAD_DIM], axis=-1)
    q = q.reshape(B, nb, BLOCK, SWA_KV_HEADS, G, SWA_HEAD_DIM)
    k = k.reshape(B, nb, BLOCK, SWA_KV_HEADS, SWA_HEAD_DIM)
    v = v.reshape(B, nb, BLOCK, SWA_KV_HEADS, SWA_HEAD_DIM)

    def with_prev(t):
        prev = jnp.pad(t[:, :-1], ((0, 0), (1, 0), (0, 0), (0, 0), (0, 0)))
        return jnp.concatenate([prev, t], axis=2)

    kb, vb = with_prev(k), with_prev(v)
    s = jnp.einsum('bnqhgd,bnkhd->bnhgqk', q, kb).astype(jnp.float32) * (SWA_HEAD_DIM ** -0.5)

    qi = jnp.arange(BLOCK)[:, None]
    kj = jnp.arange(2 * BLOCK)[None, :]
    dist = qi + BLOCK - kj
    bias = rel_bias.astype(jnp.float32)[t5_causal_bucket(jnp.maximum(dist, 0))]
    bias = bias.transpose(2, 0, 1).reshape(SWA_KV_HEADS, G, BLOCK, 2 * BLOCK)
    band = (dist >= 0) & (dist < SWA_WINDOW)
    valid = band[None] & ((jnp.arange(nb)[:, None, None] > 0) | (kj[None] >= BLOCK))
    s = jnp.where(valid[None, :, None, None], s + bias, -jnp.inf)

    sink = jnp.broadcast_to(sinks.astype(jnp.float32).reshape(1, 1, SWA_KV_HEADS, G, 1, 1),
                            s.shape[:-1] + (1,))
    p = jax.nn.softmax(jnp.concatenate([s, sink], axis=-1), axis=-1)[..., :-1]
    o = jnp.einsum('bnhgqk,bnkhd->bnqhgd', p.astype(vb.dtype), vb)
    return o.reshape(B, S, SWA_HEADS * SWA_HEAD_DIM) @ w_o


def stick_breaking_attention(h, w_qkv, w_o):
    B, S, _ = h.shape
    nb = S // BLOCK
    q, k, v = jnp.split(h @ w_qkv, 3, axis=-1)
    q = q.reshape(B, nb, BLOCK, SB_HEADS, SB_HEAD_DIM).transpose(1, 0, 3, 2, 4)
    k = k.reshape(B, S, SB_HEADS, SB_HEAD_DIM)
    v = v.reshape(B, S, SB_HEADS, SB_HEAD_DIM)
    key_pos = jnp.arange(S)
    scale = SB_HEAD_DIM ** -0.5

    def block(args):
        qb, b_idx = args
        z = jnp.einsum('bhqd,bkhd->bhqk', qb, k).astype(jnp.float32) * scale
        q_pos = b_idx * BLOCK + jnp.arange(BLOCK)
        before = key_pos[None, :] < q_pos[:, None]
        log_fail = jnp.where(before, jax.nn.log_sigmoid(-z), 0.0)
        between = lax.cumsum(log_fail, axis=3, reverse=True) - log_fail
        a = jnp.where(before, jnp.exp(jax.nn.log_sigmoid(z) + between), 0.0)
        return jnp.einsum('bhqk,bkhd->bqhd', a.astype(v.dtype), v)

    o = lax.map(block, (q, jnp.arange(nb)))
    o = o.transpose(1, 0, 2, 3, 4).reshape(B, S, SB_HEADS * SB_HEAD_DIM)
    return o @ w_o


def causal_attention_blocked(q, k, v, scale):
    B, S, H, _ = q.shape
    nb = S // BLOCK
    qb = q.reshape(B, nb, BLOCK, H, -1).transpose(1, 0, 2, 3, 4)
    key_pos = jnp.arange(S)

    def block(args):
        qblk, b_idx = args
        s = jnp.einsum('bqhd,bkhd->bhqk', qblk, k).astype(jnp.float32) * scale
        q_pos = b_idx * BLOCK + jnp.arange(BLOCK)
        s = jnp.where(key_pos[None, :] <= q_pos[:, None], s, -jnp.inf)
        p = jax.nn.softmax(s, axis=-1).astype(v.dtype)
        return jnp.einsum('bhqk,bkhd->bqhd', p, v)

    o = lax.map(block, (qb, jnp.arange(nb)))
    return o.transpose(1, 0, 2, 3, 4).reshape(B, S, H * v.shape[-1])


def mla_attention(h, w_down, q_norm, w_uq, kv_norm, w_ukv, w_o):
    B, S, _ = h.shape
    c = h @ w_down
    c_q, c_kv, k_rope = jnp.split(c, [MLA_Q_RANK, MLA_Q_RANK + MLA_KV_RANK], axis=-1)
    cos, sin = rope_tables(S, MLA_ROPE_DIM)
    q = (rms_norm(c_q, q_norm) @ w_uq).reshape(B, S, MLA_HEADS, MLA_NOPE_DIM + MLA_ROPE_DIM)
    q_nope, q_rope = jnp.split(q, [MLA_NOPE_DIM], axis=-1)
    q_rope = apply_rope(q_rope, cos, sin)
    kv = (rms_norm(c_kv, kv_norm) @ w_ukv).reshape(B, S, MLA_HEADS, MLA_NOPE_DIM + MLA_V_DIM)
    k_nope, v = jnp.split(kv, [MLA_NOPE_DIM], axis=-1)
    k_rope = apply_rope(k_rope[:, :, None, :], cos, sin)
    q_cat = jnp.concatenate([q_nope, q_rope], axis=-1)
    k_cat = jnp.concatenate([k_nope, jnp.broadcast_to(k_rope, (B, S, MLA_HEADS, MLA_ROPE_DIM))], axis=-1)
    o = causal_attention_blocked(q_cat, k_cat, v, (MLA_NOPE_DIM + MLA_ROPE_DIM) ** -0.5)
    return o @ w_o


def swiglu(h, w_gate, w_up, w_down):
    return (jax.nn.silu(h @ w_gate) * (h @ w_up)) @ w_down


def moe_swiglu(h, router, w_gate, w_up, w_down):
    B, S, D = h.shape
    t = h.reshape(B * S, D)
    logits = (t @ router).astype(jnp.float32)
    top_vals, top_idx = lax.top_k(logits, TOP_K)
    gates = jax.nn.softmax(top_vals, axis=-1)
    combine = jnp.sum(jax.nn.one_hot(top_idx, N_EXPERTS, dtype=jnp.float32) * gates[..., None], axis=1)
    out = jnp.zeros_like(t)
    for e in range(N_EXPERTS):
        out = out + combine[:, e:e + 1].astype(t.dtype) * swiglu(t, w_gate[e], w_up[e], w_down[e])
    return out.reshape(B, S, D)


def _n_layers_of(mixer_id):
    return len(range(mixer_id, DEPTH, N_MIXERS))


def setup_inputs(seed: int = 0) -> dict:
    key = jax.random.key(seed)
    ks = jax.random.split(key, 24)
    f32 = jnp.float32
    nA, nB, nC = _n_layers_of(0), _n_layers_of(1), _n_layers_of(2)
    n_dense, n_moe = len(range(0, DEPTH, 2)), len(range(1, DEPTH, 2))

    def w(k, shape, fan_in):
        return jax.random.normal(k, shape, f32) * (fan_in ** -0.5)

    def gain(k, shape):
        return 1.0 + 0.02 * jax.random.normal(k, shape, f32)

    qkv_a = (SWA_HEADS + 2 * SWA_KV_HEADS) * SWA_HEAD_DIM
    mla_down = MLA_Q_RANK + MLA_KV_RANK + MLA_ROPE_DIM
    return {
        'x': jax.random.normal(ks[0], (BATCH, SEQ, D_MODEL), f32),
        'rel_bias': 0.5 * jax.random.normal(ks[1], (REL_BUCKETS, SWA_HEADS), f32),
        'attn_norm': gain(ks[2], (DEPTH, D_MODEL)),
        'ffn_norm': gain(ks[3], (DEPTH, D_MODEL)),
        'final_norm': gain(ks[4], (D_MODEL,)),
        'swa_w_qkv': w(ks[5], (nA, D_MODEL, qkv_a), D_MODEL),
        'swa_b_qkv': 0.02 * jax.random.normal(ks[6], (nA, qkv_a), f32),
        'swa_sinks': 0.5 * jax.random.normal(ks[7], (nA, SWA_HEADS), f32),
        'swa_w_o': w(ks[8], (nA, SWA_HEADS * SWA_HEAD_DIM, D_MODEL), SWA_HEADS * SWA_HEAD_DIM),
        'sb_w_qkv': w(ks[9], (nB, D_MODEL, 3 * SB_HEADS * SB_HEAD_DIM), D_MODEL),
        'sb_w_o': w(ks[10], (nB, SB_HEADS * SB_HEAD_DIM, D_MODEL), SB_HEADS * SB_HEAD_DIM),
        'mla_w_down': w(ks[11], (nC, D_MODEL, mla_down), D_MODEL),
        'mla_q_norm': gain(ks[12], (nC, MLA_Q_RANK)),
        'mla_w_uq': w(ks[13], (nC, MLA_Q_RANK, MLA_HEADS * (MLA_NOPE_DIM + MLA_ROPE_DIM)), MLA_Q_RANK),
        'mla_kv_norm': gain(ks[14], (nC, MLA_KV_RANK)),
        'mla_w_ukv': w(ks[15], (nC, MLA_KV_RANK, MLA_HEADS * (MLA_NOPE_DIM + MLA_V_DIM)), MLA_KV_RANK),
        'mla_w_o': w(ks[16], (nC, MLA_HEADS * MLA_V_DIM, D_MODEL), MLA_HEADS * MLA_V_DIM),
        'ffn_w_gate': w(ks[17], (n_dense, D_MODEL, FFN_DIM), D_MODEL),
        'ffn_w_up': w(ks[18], (n_dense, D_MODEL, FFN_DIM), D_MODEL),
        'ffn_w_down': w(ks[19], (n_dense, FFN_DIM, D_MODEL), FFN_DIM),
        'moe_router': w(ks[20], (n_moe, D_MODEL, N_EXPERTS), D_MODEL),
        'moe_w_gate': w(ks[21], (n_moe, N_EXPERTS, D_MODEL, EXPERT_DIM), D_MODEL),
        'moe_w_up': w(ks[22], (n_moe, N_EXPERTS, D_MODEL, EXPERT_DIM), D_MODEL),
        'moe_w_down': w(ks[23], (n_moe, N_EXPERTS, EXPERT_DIM, D_MODEL), EXPERT_DIM),
    }


def reference(x, rel_bias, attn_norm, ffn_norm, final_norm,
              swa_w_qkv, swa_b_qkv, swa_sinks, swa_w_o,
              sb_w_qkv, sb_w_o,
              mla_w_down, mla_q_norm, mla_w_uq, mla_kv_norm, mla_w_ukv, mla_w_o,
              ffn_w_gate, ffn_w_up, ffn_w_down,
              moe_router, moe_w_gate, moe_w_up, moe_w_down):
    for i in range(DEPTH):
        h = rms_norm(x, attn_norm[i])
        mixer, j = i % N_MIXERS, i // N_MIXERS
        if mixer == 0:
            mix = swa_sink_attention(h, swa_w_qkv[j], swa_b_qkv[j], swa_sinks[j], swa_w_o[j], rel_bias)
        elif mixer == 1:
            mix = stick_breaking_attention(h, sb_w_qkv[j], sb_w_o[j])
        else:
            mix = mla_attention(h, mla_w_down[j], mla_q_norm[j], mla_w_uq[j],
                                mla_kv_norm[j], mla_w_ukv[j], mla_w_o[j])
        x = x + mix
        h = rms_norm(x, ffn_norm[i])
        f = i // 2
        if i % 2 == 0:
            x = x + swiglu(h, ffn_w_gate[f], ffn_w_up[f], ffn_w_down[f])
        else:
            x = x + moe_swiglu(h, moe_router[f], moe_w_gate[f], moe_w_up[f], moe_w_down[f])
    return rms_norm(x, final_norm)
```

```cpp
#include <hip/hip_runtime.h>
#include <cstdio>
#include <cstdint>

#ifndef MK_PER_PHASE
#define MK_PER_PHASE 0
#endif
#ifndef NAIVE_ATTN
#define NAIVE_ATTN 0
#endif

#ifndef PROBE_A
#define PROBE_A -1
#endif
#ifndef PROBE_B
#define PROBE_B -1
#endif
#ifndef PROBE_C
#define PROBE_C -1
#endif
#define GAS __attribute__((address_space(1)))
#define LAS __attribute__((address_space(3)))

namespace pg8 {
#define PG8_LAS __attribute__((address_space(3)))
typedef unsigned short bf16_t;
typedef short bf16x8 __attribute__((ext_vector_type(8)));
typedef float f32x4 __attribute__((ext_vector_type(4)));
typedef float f32x2 __attribute__((ext_vector_type(2)));
typedef unsigned u32x4 __attribute__((ext_vector_type(4)));
constexpr int BM = 256, BK = 64, HALF = 128, HTB = HALF * BK * 2  , STAGE_BYTES = 8 * HTB, NXCD = 8, WGM = 8;

__host__ __device__ __forceinline__ int lds_byte(int r, int c) { const int st = (r >> 4) * 2 + (c >> 5), rr = r & 15, cc = c & 31, ob = rr * 64 + cc * 2; return st * 1024 + (ob ^ (((ob >> 9) & 1) << 5)); }
__host__ __device__ __forceinline__ void stage_rc(int b, int& R, int& C) { const int st = b / 1024, sb = b % 1024, swz = sb ^ (((sb >> 9) & 1) << 5); R = (st >> 1) * 16 + swz / 64; C = (st & 1) * 32 + (swz % 64) / 2; }
__host__ __device__ __forceinline__ int perm32(int rho) { const int n = rho >> 4, i = rho & 15; return 8 * (i >> 2) + 4 * n + (i & 3); }

struct Unit { int pm, pn; long bo; int so; long ao, oo; };
typedef int i32x4 __attribute__((ext_vector_type(4)));
template <bool I8> struct AccSel { typedef f32x4 type; };
template <> struct AccSel<true> { typedef i32x4 type; };
template <class T> struct IsI8 { static constexpr bool v = false; };
template <> struct IsI8<i32x4> { static constexpr bool v = true; };
__device__ __forceinline__ void mma16(f32x4& c, bf16x8 b, bf16x8 a) { c = __builtin_amdgcn_mfma_f32_16x16x32_bf16(b, a, c, 0, 0, 0); }
__device__ __forceinline__ void mma16(i32x4& c, bf16x8 b, bf16x8 a) { c = __builtin_amdgcn_mfma_i32_16x16x64_i8(__builtin_bit_cast(i32x4, b), __builtin_bit_cast(i32x4, a), c, 0, 0, 0); }
__device__ __forceinline__ f32x4 accval(const f32x4& a, float, const f32x4&) { return a; }
__device__ __forceinline__ f32x4 accval(const i32x4& a, float sa, const f32x4& sb) { return __builtin_convertvector(a, f32x4) * (sb * sa); }
struct Gemm { const bf16_t* A; const bf16_t* Bt; int M, N, K, ld; };

struct StaticOrder {
    int nM, nN, nwg, G, c;
    __device__ void init(int M, int N, int G_, int c_) { nM = M / BM; nN = N / BM; nwg = nM * nN; G = G_; c = c_; }
    __device__ bool next(int i, Unit& u) const {
        const long L = (long)i * G + c; if (L >= nwg) return false;
        int wgid = (int)L; { const int q = nwg / NXCD, r = nwg % NXCD, xcd = wgid % NXCD, off = wgid / NXCD; wgid = (xcd < r ? xcd * (q + 1) : r * (q + 1) + (xcd - r) * q) + off; }
        const int nig = WGM * nN, gid = wgid / nig, fm = gid * WGM, gsz = (nM - fm) < WGM ? (nM - fm) : WGM;
        u.pm = fm + ((wgid % nig) % gsz); u.pn = (wgid % nig) / gsz; u.bo = 0; u.so = 0; u.ao = 0; u.oo = 0; return true;
    }
    __device__ __forceinline__ void a_ready(const Unit&) const {}
    __device__ __forceinline__ void done(const Unit&) const {}
};
struct GroupedOrder {
    int nM, nN, nwg, G, c; int tp1, tp2, tp3, tp4, tp5, tp6, tp7; long estride; int sstride;
    __device__ bool next(int i, Unit& u) const {
        const long L = (long)i * G + c; if (L >= nwg) return false;
        int wgid = (int)L; { const int q = nwg / NXCD, r = nwg % NXCD, xcd = wgid % NXCD, off = wgid / NXCD; wgid = (xcd < r ? xcd * (q + 1) : r * (q + 1) + (xcd - r) * q) + off; }
        const int nig = WGM * nN, gid = wgid / nig, fm = gid * WGM, gsz = (nM - fm) < WGM ? (nM - fm) : WGM;
        u.pm = fm + ((wgid % nig) % gsz); u.pn = (wgid % nig) / gsz;
        const int e = (u.pm >= tp1) + (u.pm >= tp2) + (u.pm >= tp3) + (u.pm >= tp4) + (u.pm >= tp5) + (u.pm >= tp6) + (u.pm >= tp7);
        u.bo = (long)e * estride; u.so = e * sstride; u.ao = 0; u.oo = 0; return true;
    }
    __device__ __forceinline__ void a_ready(const Unit&) const {}
    __device__ __forceinline__ void done(const Unit&) const {}
};

struct SplitKOrder {
    int nrem, G, c; int tp1, tp2, tp3, tp4, tp5, tp6, tp7; long estride; long pstride;
    __device__ bool next(int i, Unit& u) const {
        const long L = (long)i * G + c; if (L >= (long)nrem * 28) return false;
        const int p = (int)L % 7, un = (int)L / 7; u.pn = un & 3; u.pm = 256 + (un >> 2);
        const int e = (u.pm >= tp1) + (u.pm >= tp2) + (u.pm >= tp3) + (u.pm >= tp4) + (u.pm >= tp5) + (u.pm >= tp6) + (u.pm >= tp7);
        u.bo = (long)e * estride + (long)p * 1024; u.ao = (long)p * 1024; u.so = 0; u.oo = (long)p * pstride - (long)65536 * 1024; return true;
    }
    __device__ __forceinline__ void a_ready(const Unit&) const {}
    __device__ __forceinline__ void done(const Unit&) const {}
};

__device__ __forceinline__ unsigned cvt_pk_bf16(float lo, float hi) { unsigned r; asm volatile("v_cvt_pk_bf16_f32 %0, %1, %2" : "=v"(r) : "v"(lo), "v"(hi)); return r; }

struct EpiBf16S {
    static constexpr bool PERM = true, AFTER_DRAIN = false;
    bf16_t* O; int ldc; const float* bias; int nsc; float sc; const float* sA; const float* sB;
    template <class AccT>
    __device__ __forceinline__ void operator()(const AccT (&acc)[2][2][4][2], const Unit& u, int wr, int wc, int fr, int fq) const {
        constexpr bool I8 = IsI8<AccT>::v;
        const int row0 = u.pm * BM + wr * 64 + fr, col0 = u.pn * BM + wc * 32 + 8 * fq;
        const float s = (u.pn < nsc) ? sc : 1.f;
        f32x4 bv[2][2], sb[2][2];
#pragma unroll
        for (int bj = 0; bj < 2; ++bj)
#pragma unroll
            for (int n = 0; n < 2; ++n) sb[bj][n] = I8 ? *(const f32x4*)(sB + u.so + col0 + bj * HALF + 4 * n) : (f32x4){1.f, 1.f, 1.f, 1.f};
#pragma unroll
        for (int bj = 0; bj < 2; ++bj)
#pragma unroll
            for (int n = 0; n < 2; ++n) bv[bj][n] = bias ? *(const f32x4*)(bias + col0 + bj * HALF + 4 * n) : (f32x4){0.f, 0.f, 0.f, 0.f};
#pragma unroll
        for (int ai = 0; ai < 2; ++ai)
#pragma unroll
            for (int m = 0; m < 4; ++m) { bf16_t* rowp = O + u.oo + (size_t)(row0 + ai * HALF + m * 16) * ldc + col0;
                const float sa = I8 ? sA[row0 + ai * HALF + m * 16] : 1.f;
#pragma unroll
                for (int bj = 0; bj < 2; ++bj) { f32x4 v0 = (accval(acc[ai][bj][m][0], sa, sb[bj][0]) + bv[bj][0]) * s, v1 = (accval(acc[ai][bj][m][1], sa, sb[bj][1]) + bv[bj][1]) * s;
                    u32x4 w; w.x = cvt_pk_bf16(v0[0], v0[1]); w.y = cvt_pk_bf16(v0[2], v0[3]); w.z = cvt_pk_bf16(v1[0], v1[1]); w.w = cvt_pk_bf16(v1[2], v1[3]);
                    *(u32x4*)(rowp + bj * HALF) = w; } }
    }
};
__device__ __forceinline__ float silu_mul(float g, float u) { return g * u * __builtin_amdgcn_rcpf(1.f + __builtin_amdgcn_exp2f(-1.4426950408889634f * g)); }
struct EpiSwiGLU {
    static constexpr bool PERM = true, AFTER_DRAIN = false;
    bf16_t* O; int ldc; const float* sA; const float* sB;
    template <class AccT>
    __device__ __forceinline__ void operator()(const AccT (&acc)[2][2][4][2], const Unit& u, int wr, int wc, int fr, int fq) const {
        constexpr bool I8 = IsI8<AccT>::v;
        const int row0 = u.pm * BM + wr * 64 + fr, col0 = u.pn * HALF + wc * 32 + 8 * fq, colb = u.pn * BM + wc * 32 + 8 * fq;
        f32x4 sb[2][2];
#pragma unroll
        for (int bj = 0; bj < 2; ++bj)
#pragma unroll
            for (int n = 0; n < 2; ++n) sb[bj][n] = I8 ? *(const f32x4*)(sB + u.so + colb + bj * HALF + 4 * n) : (f32x4){1.f, 1.f, 1.f, 1.f};
#pragma unroll
        for (int ai = 0; ai < 2; ++ai)
#pragma unroll
            for (int m = 0; m < 4; ++m) { bf16_t* rowp = O + u.oo + (size_t)(row0 + ai * HALF + m * 16) * ldc + col0;
                const float sa = I8 ? sA[row0 + ai * HALF + m * 16] : 1.f;
                const f32x4 g0 = accval(acc[ai][0][m][0], sa, sb[0][0]), g1 = accval(acc[ai][0][m][1], sa, sb[0][1]), u0 = accval(acc[ai][1][m][0], sa, sb[1][0]), u1 = accval(acc[ai][1][m][1], sa, sb[1][1]);
                u32x4 w; w.x = cvt_pk_bf16(silu_mul(g0[0], u0[0]), silu_mul(g0[1], u0[1])); w.y = cvt_pk_bf16(silu_mul(g0[2], u0[2]), silu_mul(g0[3], u0[3]));
                w.z = cvt_pk_bf16(silu_mul(g1[0], u1[0]), silu_mul(g1[1], u1[1])); w.w = cvt_pk_bf16(silu_mul(g1[2], u1[2]), silu_mul(g1[3], u1[3]));
                *(u32x4*)rowp = w; }
    }
};
struct EpiResF32 {
    static constexpr bool PERM = false, AFTER_DRAIN = false;
    const float* base; float* out; int ldc;
    __device__ __forceinline__ void operator()(const f32x4 (&acc)[2][2][4][2], const Unit& u, int wr, int wc, int fr, int fq) const {
        const int row0 = u.pm * BM + wr * 64 + fr, col0 = u.pn * BM + wc * 32 + 4 * fq;
#pragma unroll
        for (int ai = 0; ai < 2; ++ai)
#pragma unroll
            for (int m = 0; m < 4; ++m) { const size_t off = (size_t)(row0 + ai * HALF + m * 16) * ldc + col0;
#pragma unroll
                for (int bj = 0; bj < 2; ++bj)
#pragma unroll
                    for (int n = 0; n < 2; ++n) { const f32x4 bs = *(const f32x4*)(base + off + bj * HALF + n * 16); *(f32x4*)(out + off + bj * HALF + n * 16) = bs + acc[ai][bj][m][n]; } }
    }
};

template <class Epi, class Sched, bool ALIGN_EPI = false, bool SP2 = false, bool I8 = false>
__device__ __forceinline__ void gemm_phase(PG8_LAS unsigned char* lds, const Gemm g, const Sched& S, const Epi& E) {
    const int tid = threadIdx.x, wid = __builtin_amdgcn_readfirstlane(tid >> 6), lane = tid & 63, wr = wid >> 2, wc = wid & 3, fr = lane & 15, fq = lane >> 4;
    constexpr int ES = I8 ? 1 : 2;
    typedef typename AccSel<I8>::type acc_t;
    const int K = g.K, nt = K * ES / (BK * 2);
    unsigned voffA[2], voffB[2];
#pragma unroll
    for (int i = 0; i < 2; ++i) { int R, C; stage_rc(tid * 16 + i * 8192, R, C); const int Rb = Epi::PERM ? ((R & ~31) + perm32(R & 31)) : R;
        voffA[i] = (unsigned)(R * g.ld * ES + C * 2); voffB[i] = (unsigned)(Rb * g.ld * ES + C * 2); }
    const size_t kstep = (size_t)(BK * 2);
    const size_t hstep = (size_t)HALF * g.ld * ES;
    const size_t tstep = 2 * hstep;
    const unsigned ldsw = (unsigned)wid * 1024u;
    const int aoff = lds_byte(wr * 64 + fr, fq * 8), boff = lds_byte(wc * 32 + fr, fq * 8);
#define PG8_SA(b, h) (((b) * 2 + (h)) * HTB)
#define PG8_SB(b, h) ((4 + (b) * 2 + (h)) * HTB)
#define PG8_STAGE(bufoff, gbase, voff) do { _Pragma("unroll") for (int _i = 0; _i < 2; ++_i) \
        __builtin_amdgcn_global_load_lds((const unsigned*)((const char*)(gbase) + (voff)[_i]), (PG8_LAS unsigned*)(lds + (bufoff) + ldsw + _i * 8192), 16, 0, 0); } while (0)
#define PG8_LDA(dst, b, h) do { _Pragma("unroll") for (int m = 0; m < 4; ++m) _Pragma("unroll") for (int k = 0; k < 2; ++k) dst[m][k] = *(const PG8_LAS bf16x8*)(lds + PG8_SA(b, h) + aoff + m * 2048 + k * 1024); } while (0)
#define PG8_LDB(dst, b, h) do { _Pragma("unroll") for (int n = 0; n < 2; ++n) _Pragma("unroll") for (int k = 0; k < 2; ++k) dst[n][k] = *(const PG8_LAS bf16x8*)(lds + PG8_SB(b, h) + boff + n * 2048 + k * 1024); } while (0)
#define PG8_MMA(ai, bj, At, Bt) do { __builtin_amdgcn_s_setprio(1); _Pragma("unroll") for (int m = 0; m < 4; ++m) _Pragma("unroll") for (int n = 0; n < 2; ++n) _Pragma("unroll") for (int k = 0; k < 2; ++k) \
        mma16(acc[ai][bj][m][n], Bt[n][k], At[m][k]); __builtin_amdgcn_s_setprio(0); } while (0)
#define PG8_WAIT_V(n) asm volatile("s_waitcnt vmcnt(" #n ")" ::: "memory")
#define PG8_WAIT_L(n) asm volatile("s_waitcnt lgkmcnt(" #n ")" ::: "memory")
#define PG8_BAR __builtin_amdgcn_s_barrier()
#define PG8_SCHED __builtin_amdgcn_sched_barrier(0)
    Unit cur, nxt; int ui = 0;
    if (!S.next(0, cur)) return;
    acc_t acc[2][2][4][2];
#pragma unroll
    for (int a = 0; a < 2; ++a)
#pragma unroll
        for (int b = 0; b < 2; ++b)
#pragma unroll
            for (int m = 0; m < 4; ++m)
#pragma unroll
                for (int n = 0; n < 2; ++n) acc[a][b][m][n] = acc_t{};
    bf16x8 At[4][2], B0[2][2], B1[2][2];
    const char* cA = (const char*)g.A + cur.ao + (size_t)cur.pm * tstep; const char* cB = (const char*)g.Bt + cur.bo + (size_t)cur.pn * tstep;
    S.a_ready(cur);
    if constexpr (SP2) {
        PG8_STAGE(PG8_SB(0, 0), cB, voffB); PG8_STAGE(PG8_SB(0, 1), cB + hstep, voffB); PG8_STAGE(PG8_SA(0, 0), cA, voffA); PG8_STAGE(PG8_SA(0, 1), cA + hstep, voffA);
        if (wr == 1) PG8_BAR;
        PG8_WAIT_V(2); PG8_BAR;
        PG8_STAGE(PG8_SB(1, 0), cB + kstep, voffB); PG8_STAGE(PG8_SA(1, 0), cA + kstep, voffA); PG8_STAGE(PG8_SB(1, 1), cB + hstep + kstep, voffB);
        PG8_WAIT_V(6); PG8_BAR;
    } else {
        PG8_STAGE(PG8_SB(0, 0), cB, voffB); PG8_STAGE(PG8_SA(0, 0), cA, voffA); PG8_STAGE(PG8_SB(0, 1), cB + hstep, voffB); PG8_STAGE(PG8_SA(0, 1), cA + hstep, voffA);
        if (wr == 1) PG8_BAR;
        PG8_WAIT_V(4); PG8_BAR;
        PG8_STAGE(PG8_SB(1, 0), cB + kstep, voffB); PG8_STAGE(PG8_SA(1, 0), cA + kstep, voffA); PG8_STAGE(PG8_SB(1, 1), cB + hstep + kstep, voffB);
        PG8_WAIT_V(6); PG8_BAR;
    }
    for (;;) {
        const bool has_next = S.next(ui + 1, nxt);
        const char* nA = has_next ? (const char*)g.A + nxt.ao + (size_t)nxt.pm * tstep : cA; const char* nB = has_next ? (const char*)g.Bt + nxt.bo + (size_t)nxt.pn * tstep : cB;
        for (int t = 0; t < nt; t += 2) {
            const bool last = (t == nt - 2);
            const char* a1 = cA + (size_t)(t + 1) * kstep;
            const char* a2 = last ? nA : cA + (size_t)(t + 2) * kstep; const char* b2 = last ? nB : cB + (size_t)(t + 2) * kstep;
            const char* a3 = a2 + kstep; const char* b3 = b2 + kstep;
            if (last && has_next) S.a_ready(nxt);
            if constexpr (SP2) {
            PG8_LDB(B0, 0, 0); PG8_LDB(B1, 0, 1); PG8_SCHED; PG8_LDA(At, 0, 0); PG8_STAGE(PG8_SA(1, 1), a1 + hstep, voffA);
            PG8_WAIT_V(8); PG8_WAIT_L(0); PG8_BAR; PG8_MMA(0, 0, At, B0); PG8_MMA(0, 1, At, B1); PG8_BAR; PG8_SCHED;
            PG8_LDA(At, 0, 1); PG8_STAGE(PG8_SB(0, 0), b2, voffB); PG8_STAGE(PG8_SB(0, 1), b2 + hstep, voffB); PG8_STAGE(PG8_SA(0, 0), a2, voffA);
            PG8_WAIT_V(8); PG8_WAIT_L(0); PG8_BAR; PG8_MMA(1, 0, At, B0); PG8_MMA(1, 1, At, B1); PG8_BAR; PG8_SCHED;
            PG8_LDB(B0, 1, 0); PG8_LDB(B1, 1, 1); PG8_SCHED; PG8_LDA(At, 1, 0); PG8_STAGE(PG8_SA(0, 1), a2 + hstep, voffA);
            PG8_WAIT_V(8); PG8_WAIT_L(0); PG8_BAR; PG8_MMA(0, 0, At, B0); PG8_MMA(0, 1, At, B1); PG8_BAR; PG8_SCHED;
            PG8_LDA(At, 1, 1); PG8_STAGE(PG8_SB(1, 0), b3, voffB); PG8_STAGE(PG8_SB(1, 1), b3 + hstep, voffB); PG8_STAGE(PG8_SA(1, 0), a3, voffA);
            PG8_WAIT_V(8); PG8_WAIT_L(0); PG8_BAR; PG8_MMA(1, 0, At, B0); PG8_MMA(1, 1, At, B1); PG8_BAR; PG8_SCHED;
            } else {
            PG8_LDB(B0, 0, 0); PG8_SCHED; PG8_LDA(At, 0, 0); PG8_STAGE(PG8_SA(1, 1), a1 + hstep, voffA);
            PG8_WAIT_L(8); PG8_BAR; PG8_WAIT_L(0); PG8_MMA(0, 0, At, B0); PG8_BAR; PG8_SCHED;
            PG8_LDB(B1, 0, 1); PG8_STAGE(PG8_SB(0, 0), b2, voffB);
            PG8_BAR; PG8_WAIT_L(0); PG8_MMA(0, 1, At, B1); PG8_BAR;
            PG8_LDA(At, 0, 1); PG8_STAGE(PG8_SA(0, 0), a2, voffA);
            PG8_BAR; PG8_WAIT_L(0); PG8_MMA(1, 0, At, B0); PG8_BAR; PG8_SCHED;
            PG8_STAGE(PG8_SB(0, 1), b2 + hstep, voffB);
            PG8_WAIT_V(6); PG8_BAR; PG8_MMA(1, 1, At, B1); PG8_BAR;
            PG8_LDB(B0, 1, 0); PG8_SCHED; PG8_LDA(At, 1, 0); PG8_STAGE(PG8_SA(0, 1), a2 + hstep, voffA);
            PG8_WAIT_L(8); PG8_BAR; PG8_WAIT_L(0); PG8_MMA(0, 0, At, B0); PG8_BAR; PG8_SCHED;
            PG8_LDB(B1, 1, 1); PG8_STAGE(PG8_SB(1, 0), b3, voffB);
            PG8_BAR; PG8_WAIT_L(0); PG8_MMA(0, 1, At, B1); PG8_BAR;
            PG8_LDA(At, 1, 1); PG8_STAGE(PG8_SA(1, 0), a3, voffA);
            PG8_BAR; PG8_WAIT_L(0); PG8_MMA(1, 0, At, B0); PG8_BAR; PG8_SCHED;
            PG8_STAGE(PG8_SB(1, 1), b3 + hstep, voffB);
            PG8_WAIT_V(6); PG8_BAR; PG8_MMA(1, 1, At, B1); PG8_BAR;
            }
        }
        if constexpr (ALIGN_EPI) { if (wr == 0) PG8_BAR; }
        if constexpr (!Epi::AFTER_DRAIN) { E(acc, cur, wr, wc, fr, fq); S.done(cur); }
        if (!has_next) break;
#pragma unroll
        for (int a = 0; a < 2; ++a)
#pragma unroll
            for (int b = 0; b < 2; ++b)
#pragma unroll
                for (int m = 0; m < 4; ++m)
#pragma unroll
                    for (int n = 0; n < 2; ++n) acc[a][b][m][n] = acc_t{};
        cur = nxt; cA = nA; cB = nB; ++ui;
        if constexpr (ALIGN_EPI) { if (wr == 1) PG8_BAR; }
    }
    PG8_WAIT_V(0);
    if constexpr (!ALIGN_EPI) { if (wr == 0) PG8_BAR; }
    PG8_BAR;
    if constexpr (Epi::AFTER_DRAIN) { E.fused(acc, cur, wr, wc, fr, fq, lds, wid, lane); S.done(cur); }
#undef PG8_SA
#undef PG8_SB
#undef PG8_STAGE
#undef PG8_LDA
#undef PG8_LDB
#undef PG8_MMA
#undef PG8_WAIT_V
#undef PG8_WAIT_L
#undef PG8_BAR
#undef PG8_SCHED
}
}

namespace att {
typedef unsigned short bf16;
typedef short bf16x8 __attribute__((ext_vector_type(8)));
typedef short s16x4 __attribute__((ext_vector_type(4)));
typedef float f32x16 __attribute__((ext_vector_type(16)));
typedef float f32x4 __attribute__((ext_vector_type(4)));
typedef unsigned u32x4 __attribute__((ext_vector_type(4)));
typedef float f32x2_t __attribute__((ext_vector_type(2))); typedef __bf16 bf16x2_t __attribute__((ext_vector_type(2)));
constexpr int SEQ = 4096;
constexpr float LOG2E = 1.4426950408889634f;
struct Args { const bf16* Q; int qpitch, qhs; const bf16* K; int kpitch, khs; const bf16* K2; const bf16* V; int vpitch, vhs; bf16* O; const float* cosT; const float* sinT; const float* relb; const float* sinks; };

__device__ __forceinline__ int crow(int r, int hi) { return (r & 3) + 8 * (r >> 2) + 4 * hi; }
__device__ __forceinline__ unsigned cvtpk(float lo, float hi) { f32x2_t v = {lo, hi}; bf16x2_t b = __builtin_convertvector(v, bf16x2_t); return __builtin_bit_cast(unsigned, b); }
__device__ __forceinline__ float bf2f(unsigned short h) { return __builtin_bit_cast(float, (unsigned)h << 16); }
__device__ __forceinline__ unsigned short f2bf(float f) { unsigned u = __builtin_bit_cast(unsigned, f); return (unsigned short)((u + 0x7fffu + ((u >> 16) & 1u)) >> 16); }
__device__ __forceinline__ float ex2(float x) { return __builtin_amdgcn_exp2f(x); }
__device__ __forceinline__ float lg2(float x) { return __builtin_amdgcn_logf(x); }
#define ATT_SBAR() __builtin_amdgcn_sched_barrier(0)
__device__ __forceinline__ void pv(f32x16* o, int vb, bf16x8 pa0, bf16x8 pa1, bf16x8 pa2, bf16x8 pa3) {
  s16x4 lo0[4], hi0[4], lo1[4], hi1[4];
#pragma unroll
  for (int ks = 0; ks < 4; ++ks) {
    asm volatile("ds_read_b64_tr_b16 %0,%1 offset:%c2" : "=&v"(lo0[ks]) : "v"(vb), "i"(ks * 1024) : "memory");
    asm volatile("ds_read_b64_tr_b16 %0,%1 offset:%c2" : "=&v"(hi0[ks]) : "v"(vb), "i"(ks * 1024 + 512) : "memory"); }
#pragma unroll
  for (int ks = 0; ks < 4; ++ks) {
    asm volatile("ds_read_b64_tr_b16 %0,%1 offset:%c2" : "=&v"(lo1[ks]) : "v"(vb), "i"(4096 + ks * 1024) : "memory");
    asm volatile("ds_read_b64_tr_b16 %0,%1 offset:%c2" : "=&v"(hi1[ks]) : "v"(vb), "i"(4096 + ks * 1024 + 512) : "memory"); }
  asm volatile("s_waitcnt lgkmcnt(8)" : "+v"(lo0[0]), "+v"(hi0[0]), "+v"(lo0[1]), "+v"(hi0[1]), "+v"(lo0[2]), "+v"(hi0[2]), "+v"(lo0[3]), "+v"(hi0[3]) :: "memory"); ATT_SBAR();
#define ATT_PK(lo, hi, k) (bf16x8){lo[k][0], lo[k][1], lo[k][2], lo[k][3], hi[k][0], hi[k][1], hi[k][2], hi[k][3]}
  o[0] = __builtin_amdgcn_mfma_f32_32x32x16_bf16(pa0, ATT_PK(lo0, hi0, 0), o[0], 0, 0, 0);
  o[0] = __builtin_amdgcn_mfma_f32_32x32x16_bf16(pa1, ATT_PK(lo0, hi0, 1), o[0], 0, 0, 0);
  o[0] = __builtin_amdgcn_mfma_f32_32x32x16_bf16(pa2, ATT_PK(lo0, hi0, 2), o[0], 0, 0, 0);
  o[0] = __builtin_amdgcn_mfma_f32_32x32x16_bf16(pa3, ATT_PK(lo0, hi0, 3), o[0], 0, 0, 0);
  asm volatile("s_waitcnt lgkmcnt(0)" : "+v"(lo1[0]), "+v"(hi1[0]), "+v"(lo1[1]), "+v"(hi1[1]), "+v"(lo1[2]), "+v"(hi1[2]), "+v"(lo1[3]), "+v"(hi1[3]) :: "memory"); ATT_SBAR();
  o[1] = __builtin_amdgcn_mfma_f32_32x32x16_bf16(pa0, ATT_PK(lo1, hi1, 0), o[1], 0, 0, 0);
  o[1] = __builtin_amdgcn_mfma_f32_32x32x16_bf16(pa1, ATT_PK(lo1, hi1, 1), o[1], 0, 0, 0);
  o[1] = __builtin_amdgcn_mfma_f32_32x32x16_bf16(pa2, ATT_PK(lo1, hi1, 2), o[1], 0, 0, 0);
  o[1] = __builtin_amdgcn_mfma_f32_32x32x16_bf16(pa3, ATT_PK(lo1, hi1, 3), o[1], 0, 0, 0);
#undef ATT_PK
}
__device__ __forceinline__ float max3f(float a, float b, float c) { float r; asm("v_max3_f32 %0, %1, %2, %3" : "=v"(r) : "v"(a), "v"(b), "v"(c)); return r; }
__device__ __forceinline__ float xmax(float v) { auto rr = __builtin_amdgcn_permlane32_swap(__float_as_uint(v), __float_as_uint(v), false, false); return fmaxf(__uint_as_float(rr[0]), __uint_as_float(rr[1])); }
__device__ __forceinline__ float xsum(float v) { auto rr = __builtin_amdgcn_permlane32_swap(__float_as_uint(v), __float_as_uint(v), false, false); return __uint_as_float(rr[0]) + __uint_as_float(rr[1]); }

__device__ __forceinline__ void softmax_tile(f32x16& p0, f32x16& p1, float& m, float& l, f32x16& negm, f32x16& o0, f32x16& o1, f32x16& q0, f32x16& q1, LAS float* wsf, int r32, int hi) {
  constexpr float THR = 8.f;
  float a = max3f(p0[0], p0[1], p1[0]), b = max3f(p0[2], p0[3], p1[1]); a = max3f(a, p1[2], p1[3]);
#pragma unroll
  for (int r = 4; r < 16; r += 4) { a = max3f(a, p0[r], p0[r + 1]); b = max3f(b, p0[r + 2], p0[r + 3]); a = max3f(a, p1[r], p1[r + 1]); b = max3f(b, p1[r + 2], p1[r + 3]); }
  const float rm = xmax(max3f(a, b, b));
  if (__any(rm > THR || (l == 0.f && rm < -40.f && rm > -1e29f))) {
    const float dl = (rm > 0.f || (l == 0.f && rm < -40.f && rm > -1e29f)) ? rm : 0.f;
    m += dl;
#pragma unroll
    for (int r = 0; r < 16; ++r) { negm[r] = -m; p0[r] -= dl; p1[r] -= dl; q0[r] -= dl; q1[r] -= dl; }
    const float f = ex2(-dl); l *= f;
    if (hi == 0) wsf[r32] = f;
#pragma unroll
    for (int r = 0; r < 16; ++r) { const float fr = wsf[crow(r, hi)]; o0[r] *= fr; o1[r] *= fr; }
  }
  float rs = 0.f;
#pragma unroll
  for (int r = 0; r < 16; ++r) { p0[r] = ex2(p0[r]); p1[r] = ex2(p1[r]); rs += p0[r] + p1[r]; }
  l += xsum(rs);
}

template <int MODE> struct Lay {
  static constexpr int DKC = (MODE == 2) ? 12 : 8, ND0 = DKC / 2, KSLOT = DKC * 1024, VSLOT = 8192;
  static constexpr int NSL = 4;
  static constexpr int OFF_K = 0, OFF_V = NSL * KSLOT, OFF_WS = OFF_V + NSL * VSLOT, OFF_BT = OFF_WS + 8 * 256, OFF_FL = OFF_BT + 8 * 512, OFF_OST = OFF_FL + 256, TOTAL = OFF_OST + 8 * 4096;
};

template <int MODE>
__device__ __forceinline__ void attn_unit(LAS char* shm, const Args& A, int b, int hsel, int qblk) {
  typedef Lay<MODE> L;
  constexpr int ND0 = L::ND0, KSLOT = L::KSLOT, VSLOT = L::VSLOT;
  constexpr float NEG = -1e30f;
  const int tid = threadIdx.x, lane = tid & 63, r32 = lane & 31, hi = lane >> 5;
  const int wid = __builtin_amdgcn_readfirstlane(tid >> 6);
  const long rowbase = (long)b * SEQ;
  const int qrow0 = (MODE == 0) ? 32 * qblk : 256 * qblk + 32 * wid;
  const int head = (MODE == 0) ? hsel * 8 + wid : hsel;
  int tlo, thi;
  if (MODE == 0) { tlo = qrow0 >= 127 ? (qrow0 - 127) >> 6 : 0; thi = (qrow0 + 31) >> 6; } else { tlo = 0; thi = 4 * qblk + 3; }
  const int wmax = (MODE == 1) ? (qrow0 + 30) >> 6 : (qrow0 + 31) >> 6;
  const int n = thi - tlo + 1;
  LAS float* wsf = (LAS float*)(shm + L::OFF_WS) + wid * 64;
  LAS float* btab = (LAS float*)(shm + L::OFF_BT) + wid * 128;
  LAS unsigned* fl = (LAS unsigned*)(shm + L::OFF_FL);
  const int q = qrow0 + r32;
  const bf16* Qw = A.Q + (rowbase + q) * (long)A.qpitch + head * A.qhs + hi * 8;
  bf16x8 qr[ND0];
#pragma unroll
  for (int d0 = 0; d0 < ND0; ++d0) qr[d0] = *(const bf16x8*)(Qw + d0 * 16);
  if (MODE == 2) {
    const f32x4* cp = (const f32x4*)(A.cosT + q * 16 + hi * 8); const f32x4* sp = (const f32x4*)(A.sinT + q * 16 + hi * 8);
    const f32x4 c0 = cp[0], c1 = cp[1], s0 = sp[0], s1 = sp[1];
#pragma unroll
    for (int j = 0; j < 8; ++j) { const float c = j < 4 ? c0[j & 3] : c1[j & 3], s = j < 4 ? s0[j & 3] : s1[j & 3];
      const float x1 = bf2f((unsigned short)qr[ND0 - 2][j]), x2 = bf2f((unsigned short)qr[ND0 - 1][j]);
      qr[ND0 - 2][j] = (short)f2bf(x1 * c - x2 * s); qr[ND0 - 1][j] = (short)f2bf(x1 * s + x2 * c); }
  }
  float m = 0.f, l = 0.f, cp = 1.f; bool wdone = false;
  if (MODE == 0) {
    for (int d = lane; d < 128; d += 64) { int bk = d; if (d >= 16) { bk = 16 + (int)(__logf((float)d * (1.f / 16.f)) * (16.f / 2.0794415416798357f)); bk = bk > 31 ? 31 : bk; }
      btab[d] = A.relb[bk * 16 + head] * LOG2E; }
    m = A.sinks[head] * LOG2E; l = 1.f;
  }
  f32x16 negm;
#pragma unroll
  for (int r = 0; r < 16; ++r) negm[r] = (MODE == 1) ? 0.f : -m;
  f32x16 o[2]; o[0] = f32x16{}; o[1] = f32x16{};
  const bf16* ksrc = A.K + (rowbase + lane) * (long)A.kpitch + hsel * A.khs + wid * 8;
  const bf16* k2src = (MODE == 2) ? A.K2 + (rowbase + lane) * 32 + (wid & 3) * 8 : nullptr;
  const bf16* vsrc = A.V + (rowbase + 16 * (wid & 3) + (lane >> 2)) * (long)A.vpitch + hsel * A.vhs + (wid >> 2) * 32 + (lane & 3) * 8;
  const int vb0 = (int)(unsigned)(uintptr_t)(shm + L::OFF_V) + ((lane >> 4) & 1) * 32 + (lane & 3) * 8 + (4 * hi + ((lane & 15) >> 2)) * 64;
  u32x4 kreg, k2reg = (u32x4){0u, 0u, 0u, 0u}, vreg;
#define ATT_TILE(i_) ((MODE == 1) ? thi - (i_) : tlo + (i_))
#define ATT_LOAD(t_) do { kreg = *(const u32x4*)(ksrc + (long)(t_) * 64 * A.kpitch); vreg = *(const u32x4*)(vsrc + (long)(t_) * 64 * A.vpitch); \
    if (MODE == 2 && wid < 4) k2reg = *(const u32x4*)(k2src + (long)(t_) * 64 * 32); } while (0)
#define ATT_STAGE(sl_) do { *(LAS u32x4*)(shm + L::OFF_K + (sl_) * KSLOT + wid * 1024 + lane * 16) = kreg; \
    if (MODE == 2 && wid < 4) *(LAS u32x4*)(shm + L::OFF_K + (sl_) * KSLOT + (8 + wid) * 1024 + lane * 16) = k2reg; \
    *(LAS u32x4*)(shm + L::OFF_V + (sl_) * VSLOT + wid * 1024 + lane * 16) = vreg; } while (0)
#define ATT_QK(P0, P1, sl_) do { LAS const char* kb_ = shm + L::OFF_K + (sl_) * KSLOT + hi * 1024 + r32 * 16; bf16x8 kf_[2 * ND0]; \
    _Pragma("unroll") for (int d0 = 0; d0 < ND0; ++d0) { kf_[2 * d0] = *(LAS const bf16x8*)(kb_ + d0 * 2048); kf_[2 * d0 + 1] = *(LAS const bf16x8*)(kb_ + d0 * 2048 + 512); } \
    P0 = __builtin_amdgcn_mfma_f32_32x32x16_bf16(kf_[0], qr[0], negm, 0, 0, 0); P1 = __builtin_amdgcn_mfma_f32_32x32x16_bf16(kf_[1], qr[0], negm, 0, 0, 0); \
    _Pragma("unroll") for (int d0 = 1; d0 < ND0; ++d0) { P0 = __builtin_amdgcn_mfma_f32_32x32x16_bf16(kf_[2 * d0], qr[d0], P0, 0, 0, 0); P1 = __builtin_amdgcn_mfma_f32_32x32x16_bf16(kf_[2 * d0 + 1], qr[d0], P1, 0, 0, 0); } } while (0)
  ATT_LOAD(ATT_TILE(0)); ATT_STAGE(0);
  if (n > 1) ATT_LOAD(ATT_TILE(1));
  __syncthreads();
  f32x16 p0 = f32x16{}, p1 = f32x16{}, q0 = f32x16{}, q1 = f32x16{};
  if (ATT_TILE(0) <= wmax) ATT_QK(p0, p1, 0);
  int sl = 0, sln = 1;
  bool have_pv = false; int pv_sl = 0; u32x4 pw0 = (u32x4){0u, 0u, 0u, 0u}, pw1 = pw0, pw2 = pw0, pw3 = pw0;
  for (int i = 0; i < n; ++i) {
    const int t = ATT_TILE(i);
    if (i + 1 < n) ATT_STAGE(sln);
    __syncthreads();
    if (MODE == 1 && i >= 1) { const int fb = (i & 1) * 8; unsigned a = fl[fb + 0] & fl[fb + 1] & fl[fb + 2] & fl[fb + 3] & fl[fb + 4] & fl[fb + 5] & fl[fb + 6] & fl[fb + 7];
      if (__builtin_amdgcn_readfirstlane(a)) break; }
    if (i + 2 < n) ATT_LOAD(ATT_TILE(i + 2));
    if (i + 1 < n && ATT_TILE(i + 1) <= wmax && !(MODE == 1 && wdone)) ATT_QK(q0, q1, sln);
    if (have_pv) { pv(o, vb0 + pv_sl * VSLOT, __builtin_bit_cast(bf16x8, pw0), __builtin_bit_cast(bf16x8, pw1), __builtin_bit_cast(bf16x8, pw2), __builtin_bit_cast(bf16x8, pw3)); have_pv = false; }
    ATT_SBAR();
    if (t <= wmax && !(MODE == 1 && wdone)) {
      const int kt0 = t * 64;
      if (MODE == 2) {
        if (kt0 + 63 > qrow0) {
#pragma unroll
          for (int r = 0; r < 16; ++r) { const int key = kt0 + crow(r, hi); if (key > q) p0[r] = NEG; if (key + 32 > q) p1[r] = NEG; }
        }
        softmax_tile(p0, p1, m, l, negm, o[0], o[1], q0, q1, wsf, r32, hi);
      } else if (MODE == 0) {
#pragma unroll
        for (int r = 0; r < 16; ++r) { const int d0_ = q - (kt0 + crow(r, hi)), d1_ = d0_ - 32;
          const float b0_ = btab[d0_ & 127], b1_ = btab[d1_ & 127];
          p0[r] = ((unsigned)d0_ < 128u) ? p0[r] + b0_ : NEG; p1[r] = ((unsigned)d1_ < 128u) ? p1[r] + b1_ : NEG; }
        softmax_tile(p0, p1, m, l, negm, o[0], o[1], q0, q1, wsf, r32, hi);
      } else {
        const bool need_mask = (kt0 + 63 >= qrow0);
        f32x16 l0, l1;
#pragma unroll
        for (int r = 0; r < 16; ++r) {
          { const float e = ex2(-fmaxf(p0[r], -100.f)); float sg = __builtin_amdgcn_rcpf(1.f + e); float fl_ = e * sg; if (need_mask && (kt0 + crow(r, hi) >= q)) { sg = 0.f; fl_ = 1.f; } p0[r] = sg; l0[r] = fl_; }
          { const float e = ex2(-fmaxf(p1[r], -100.f)); float sg = __builtin_amdgcn_rcpf(1.f + e); float fl_ = e * sg; if (need_mask && (kt0 + 32 + crow(r, hi) >= q)) { sg = 0.f; fl_ = 1.f; } p1[r] = sg; l1[r] = fl_; }
        }
        float gs[8], pg[8];
#pragma unroll
        for (int c = 0; c < 4; ++c) { gs[c] = (l0[4 * c] * l0[4 * c + 1]) * (l0[4 * c + 2] * l0[4 * c + 3]); gs[4 + c] = (l1[4 * c] * l1[4 * c + 1]) * (l1[4 * c + 2] * l1[4 * c + 3]); }
#pragma unroll
        for (int ch = 0; ch < 8; ++ch) pg[ch] = __shfl_xor(gs[ch], 32);
        float suf = cp;
#pragma unroll
        for (int ch = 7; ch >= 4; --ch) { float run = (hi == 0) ? suf * pg[ch] : suf;
#pragma unroll
          for (int k = 3; k >= 0; --k) { const int r = 4 * (ch - 4) + k; p1[r] *= run; run *= l1[r]; }
          suf *= gs[ch] * pg[ch]; }
#pragma unroll
        for (int ch = 3; ch >= 0; --ch) { float run = (hi == 0) ? suf * pg[ch] : suf;
#pragma unroll
          for (int k = 3; k >= 0; --k) { const int r = 4 * ch + k; p0[r] *= run; run *= l0[r]; }
          suf *= gs[ch] * pg[ch]; }
        cp = suf;
        wdone = __all(cp == 0.f);
      }
      pw0 = (u32x4){cvtpk(p0[0], p0[1]), cvtpk(p0[2], p0[3]), cvtpk(p0[4], p0[5]), cvtpk(p0[6], p0[7])};
      pw1 = (u32x4){cvtpk(p0[8], p0[9]), cvtpk(p0[10], p0[11]), cvtpk(p0[12], p0[13]), cvtpk(p0[14], p0[15])};
      pw2 = (u32x4){cvtpk(p1[0], p1[1]), cvtpk(p1[2], p1[3]), cvtpk(p1[4], p1[5]), cvtpk(p1[6], p1[7])};
      pw3 = (u32x4){cvtpk(p1[8], p1[9]), cvtpk(p1[10], p1[11]), cvtpk(p1[12], p1[13]), cvtpk(p1[14], p1[15])};
      have_pv = true; pv_sl = sl;
    }
    if (MODE == 1 && lane == 0) fl[((i + 1) & 1) * 8 + wid] = wdone ? 1u : 0u;
    p0 = q0; p1 = q1;
    sl = sln; sln = (sln == L::NSL - 1) ? 0 : sln + 1;
  }
  if (have_pv) pv(o, vb0 + pv_sl * VSLOT, __builtin_bit_cast(bf16x8, pw0), __builtin_bit_cast(bf16x8, pw1), __builtin_bit_cast(bf16x8, pw2), __builtin_bit_cast(bf16x8, pw3));
#undef ATT_TILE
#undef ATT_LOAD
#undef ATT_STAGE
#undef ATT_QK
  float rli[16];
  if (MODE != 1) {
    if (hi == 0) wsf[32 + r32] = l;
#pragma unroll
    for (int r = 0; r < 16; ++r) rli[r] = __builtin_amdgcn_rcpf(wsf[32 + crow(r, hi)]);
  } else {
#pragma unroll
    for (int r = 0; r < 16; ++r) rli[r] = 1.f;
  }
  { LAS bf16* stg = (LAS bf16*)(shm + L::OFF_OST) + wid * 2048;
#pragma unroll
    for (int r = 0; r < 16; ++r) { const int orow = crow(r, hi);
#pragma unroll
      for (int d0 = 0; d0 < 2; ++d0) stg[orow * 64 + d0 * 32 + r32] = f2bf(o[d0][r] * rli[r]); }
    bf16* Ow = A.O + (rowbase + qrow0) * 1024 + head * 64;
#pragma unroll
    for (int i = 0; i < 4; ++i) { const int row = i * 8 + (lane >> 3), ch = lane & 7; const u32x4 v = *(LAS const u32x4*)(stg + row * 64 + ch * 8); *(u32x4*)(Ow + (long)row * 1024 + ch * 8) = v; } }
  __syncthreads();
}

template <int MODE>
__device__ __forceinline__ void attn_phase(LAS char* shm, const Args& A, int G, int c) {
  for (int s = c; s < 2048; s += G) {
    const int cc = s & 255, i = s >> 8;
    int b, hsel, qblk;
    if (MODE == 0) { const int u = cc * 8 + i; b = u >> 8; hsel = (u >> 7) & 1; qblk = u & 127; }
    else { const int bh = cc >> 1, par = cc & 1; b = bh >> 4; hsel = bh & 15;
      if (MODE == 2) qblk = (i & 1) ? 15 - (i - 1) - par : i + par;
      else qblk = 2 * i + par; }
    attn_unit<MODE>(shm, A, b, hsel, qblk);
  }
}

template <int MODE>
__device__ __forceinline__ void attn_naive(const Args& A, int G, int c) {
  constexpr int DK = (MODE == 2) ? 96 : 64;
  for (int ch = c; ch < 1024; ch += G) {
    const int b = ch >> 7, head = (ch >> 3) & 15, q = (ch & 7) * 512 + (int)threadIdx.x;
    const int kvh = (MODE == 0) ? head >> 3 : head;
    const long rowbase = (long)b * SEQ;
    float qv[DK];
    { const bf16* qp = A.Q + (rowbase + q) * (long)A.qpitch + head * A.qhs;
#pragma unroll
      for (int d = 0; d < DK; ++d) qv[d] = bf2f(qp[d]); }
    if (MODE == 2) {
#pragma unroll
      for (int i = 0; i < 16; ++i) { const float cs = A.cosT[q * 16 + i], sn = A.sinT[q * 16 + i]; const float x1 = qv[DK - 32 + i], x2 = qv[DK - 16 + i];
        qv[DK - 32 + i] = bf2f(f2bf(x1 * cs - x2 * sn)); qv[DK - 16 + i] = bf2f(f2bf(x1 * sn + x2 * cs)); }
    }
    float o[64];
#pragma unroll
    for (int d = 0; d < 64; ++d) o[d] = 0.f;
    float m = -1e30f, l = 0.f, carry = 0.f;
    if (MODE == 0) { m = A.sinks[head] * LOG2E; l = 1.f; }
    const int nk = (MODE == 0) ? 128 : (MODE == 1 ? q : q + 1);
    for (int j = 0; j < nk; ++j) {
      const int key = (MODE == 0) ? q - j : (MODE == 1 ? q - 1 - j : j);
      if (key < 0) break;
      const bf16* kp = A.K + (rowbase + key) * (long)A.kpitch + kvh * A.khs;
      float s = 0.f;
#pragma unroll
      for (int d = 0; d < 64; ++d) s += qv[d] * bf2f(kp[d]);
      if (MODE == 2) { const bf16* k2 = A.K2 + (rowbase + key) * 32;
#pragma unroll
        for (int d = 0; d < 32; ++d) s += qv[64 + d] * bf2f(k2[d]); }
      const bf16* vp = A.V + (rowbase + key) * (long)A.vpitch + kvh * A.vhs;
      if (MODE == 1) {
        const float lf = -(fmaxf(s, 0.f) + lg2(1.f + ex2(-fabsf(s))));
        const float a = ex2(s + lf + carry); carry += lf;
#pragma unroll
        for (int d = 0; d < 64; ++d) o[d] += a * bf2f(vp[d]);
        if (carry < -152.f) break;
      } else {
        if (MODE == 0) { const int dist = j; int bk = dist; if (dist >= 16) { bk = 16 + (int)(__logf((float)dist * (1.f / 16.f)) * (16.f / 2.0794415416798357f)); bk = bk > 31 ? 31 : bk; } s += A.relb[bk * 16 + head] * LOG2E; }
        const float mn = fmaxf(m, s), f = ex2(m - mn), p = ex2(s - mn); l = l * f + p; m = mn;
#pragma unroll
        for (int d = 0; d < 64; ++d) o[d] = o[d] * f + p * bf2f(vp[d]);
      }
    }
    const float rl = (MODE == 1) ? 1.f : 1.f / l;
    bf16* op = A.O + (rowbase + q) * 1024 + head * 64;
#pragma unroll
    for (int d = 0; d < 64; ++d) op[d] = f2bf(o[d] * rl);
  }
}
#undef ATT_SBAR
}

constexpr int NWAVES = 8;
constexpr int BATCH = 8, SEQ = 4096, D = 1024, T = BATCH * SEQ;
constexpr int FFN = 2816, NEXP = 8, EDIM = 3584, PMAX = 67584;
constexpr int SWA_N = 1280, SB_N = 3072, MLA_DN = 768, MLA_QR = 384, MLA_KVR = 256, MLA_UQN = 1536, MLA_UKVN = 2048;
constexpr float RMS_EPS = 1e-6f, LOG2E = 1.4426950408889634f;
constexpr int NPH = 34;
typedef unsigned short bf16;
typedef unsigned v4u __attribute__((ext_vector_type(4)));
typedef unsigned v2u __attribute__((ext_vector_type(2)));
typedef float f32x4 __attribute__((ext_vector_type(4)));
typedef float f32x2 __attribute__((ext_vector_type(2)));
typedef int i32x2 __attribute__((ext_vector_type(2)));
typedef GAS unsigned gu32;
#define RLX_AGENT __ATOMIC_RELAXED, __HIP_MEMORY_SCOPE_AGENT
#define LDS_WAIT() asm volatile("s_waitcnt lgkmcnt(0)" ::: "memory")

constexpr size_t MiB = 1u << 20;
constexpr size_t WS_CTL = 0, CTL_ZERO_BYTES = 1 * MiB;
constexpr size_t WS_TAB = 1 * MiB;
constexpr size_t TAB_COS = 0, TAB_SIN = 256 * 1024, TAB_TOKE = 512 * 1024, TAB_TOKG = 640 * 1024, TAB_SLOT = 896 * 1024, TAB_SA = 1152 * 1024, TAB_SAP = 1280 * 1024, TAB_SB = 1600 * 1024, TAB_WCNT = 2200 * 1024;
constexpr size_t WS_WSM = 4 * MiB;
constexpr size_t WS_WMOE = 44 * MiB;
constexpr size_t WS_H = 156 * MiB;
constexpr size_t WS_SCR = 220 * MiB;
constexpr size_t WS_YP = 814 * MiB;
constexpr size_t YP_ELEMS = (size_t)2048 * 1024;
constexpr size_t WS_END = 842 * MiB;
constexpr size_t B_SWAO = 0, B_SBO = 4194304, B_MLAUQ = 6291456, B_MLAUKV = 7471104, B_MLAO = 8519680, B_FFND = 10616832,
                 B_SWAQKV = 22151168, B_SBQKV = 24772608, B_MLAD = 27918336, B_FFNGU = 28704768, B_SM_END = 40239104;
static_assert(B_SM_END <= 40 * MiB, "small weights fit");
constexpr size_t B_MOEGU_E = (size_t)2 * EDIM * D, B_MOED = 8 * B_MOEGU_E, B_MOED_E = (size_t)D * EDIM * 2;
static_assert(B_MOED + 8 * B_MOED_E <= 112 * MiB, "moe weights fit");
constexpr int SBO_SWAQKV = 0, SBO_SBQKV = 2560, SBO_MLAD = 5632, SBO_FFNGU = 6400, SBO_MOE = 17664, SBO_END = 17664 + 2 * 57344;
constexpr size_t SC_QKV = 0;
constexpr size_t SC_C = 0, SC_CQN = 48 * MiB, SC_CKVN = 72 * MiB, SC_KROPE = 88 * MiB, SC_QM = 90 * MiB, SC_KVM = 186 * MiB;
constexpr size_t SC_DELTA = 320 * MiB;
constexpr size_t SC_ACT = 0;
constexpr size_t SC_HPERM = 0, SC_MACT = 132 * MiB;
static_assert(SC_MACT + (size_t)PMAX * EDIM * 2 <= 594 * MiB && SC_KVM + (size_t)T * MLA_UKVN * 2 <= 594 * MiB, "scratch fits");
constexpr int CW_BAR = 4096, CW_CNT = 16384, CW_CUR = 16384 + 256, CW_AMAX = 32768;
static_assert((CW_AMAX + SBO_END) * 4 <= (int)CTL_ZERO_BYTES && TAB_SB + (size_t)SBO_END * 4 <= TAB_WCNT && TAB_WCNT + 2 * 4096 * 8 <= 3 * MiB, "ctl / tab maps");

__device__ __forceinline__ unsigned f2bf(float f) { unsigned u = __builtin_bit_cast(unsigned, f); return (u + 0x7fffu + ((u >> 16) & 1u)) >> 16; }
__device__ __forceinline__ unsigned pk2(float lo, float hi) { return f2bf(lo) | (f2bf(hi) << 16); }
__device__ __forceinline__ float bflo(unsigned w) { return __builtin_bit_cast(float, w << 16); }
__device__ __forceinline__ float bfhi(unsigned w) { return __builtin_bit_cast(float, w & 0xffff0000u); }
#define XB_TMO      128
#define XB_XCNT(j)  (256  + 64 * (j))
#define XB_XSUB(j)  (1280 + 64 * (j))
#define XB_XGEN(j)  (2304 + 64 * (j))
#define XB_TOP      3328
#define XB_TOPGEN   3392
#define XCD_BAR_WORDS 3456
#define XB_SPIN_CAP (1u << 18)

__device__ __forceinline__ unsigned xb_ld(unsigned* p)              { return __hip_atomic_load(p, __ATOMIC_RELAXED, __HIP_MEMORY_SCOPE_AGENT); }
__device__ __forceinline__ unsigned xb_add(unsigned* p, unsigned v) { return __hip_atomic_fetch_add(p, v, __ATOMIC_RELAXED, __HIP_MEMORY_SCOPE_AGENT); }
__device__ __forceinline__ unsigned xb_xcc_id() { return (unsigned)__builtin_amdgcn_s_getreg((3 << 11) | 20) & 0xFu; }
#define XB_SPIN(cond, bar) do { unsigned _sp = 0; while (cond) { __builtin_amdgcn_s_sleep(1); \
    if ((++_sp & 255u) == 0u) { if (xb_ld(&(bar)[XB_TMO])) break; if (_sp > XB_SPIN_CAP) { atomicAdd(&(bar)[XB_TMO], 1u); break; } } } } while (0)

struct XcdBarrier {
    unsigned* bar; unsigned x;
    volatile LAS unsigned* st;
};

__device__ __forceinline__ XcdBarrier xcd_barrier_post(unsigned* bar, volatile LAS unsigned* st) {
    XcdBarrier b; b.bar = bar; b.x = xb_xcc_id(); b.st = st;
    if (threadIdx.x == 0) (void)xb_add(&bar[XB_XCNT(b.x)], 1u);
    return b;
}
__device__ __forceinline__ void xcd_barrier_complete(unsigned* bar, unsigned x, unsigned& nloc, unsigned& nx) {
    const unsigned G = gridDim.x * gridDim.y * gridDim.z;
    unsigned sum, cnt, mine, sp = 0u;
    for (;;) {
        sum = 0u; cnt = 0u; mine = 0u;
#pragma unroll
        for (unsigned j = 0; j < 16; ++j) { const unsigned c = xb_ld(&bar[XB_XCNT(j)]); sum += c; cnt += (c > 0u) ? 1u : 0u; mine = (j == x) ? c : mine; }
        if (sum == G) break;
        __builtin_amdgcn_s_sleep(1);
        if ((++sp & 255u) == 0u) { if (xb_ld(&bar[XB_TMO])) break; if (sp > XB_SPIN_CAP) { atomicAdd(&bar[XB_TMO], 1u); break; } }
    }
    nloc = mine > 0u ? mine : 1u; nx = cnt > 0u ? cnt : 1u;
}

__device__ __forceinline__ void xcd_barrier(const XcdBarrier& b) {
    asm volatile("s_waitcnt vmcnt(0)" ::: "memory");
    __syncthreads();
    if (threadIdx.x == 0) {
        unsigned* bar = b.bar;
        __builtin_amdgcn_s_waitcnt(0);
        unsigned nloc = b.st[0], nx = b.st[1];
        if (nloc == 0u) { xcd_barrier_complete(bar, b.x, nloc, nx); b.st[0] = nloc; b.st[1] = nx; }
        const unsigned old = xb_add(&bar[XB_XSUB(b.x)], 1u);
        const unsigned gen = old / nloc;
        if (old + 1u == (gen + 1u) * nloc) {
            __builtin_amdgcn_fence(__ATOMIC_RELEASE, "agent");
            asm volatile("s_waitcnt vmcnt(0)" ::: "memory");
            const unsigned og = xb_add(&bar[XB_TOP], 1u);
            const unsigned tg = og / nx;
            if (og + 1u == (tg + 1u) * nx) xb_add(&bar[XB_TOPGEN], 1u);
            else XB_SPIN(xb_ld(&bar[XB_TOPGEN]) == tg, bar);
            __builtin_amdgcn_fence(__ATOMIC_ACQUIRE, "agent");
            xb_add(&bar[XB_XGEN(b.x)], 1u);
            asm volatile("s_waitcnt vmcnt(0)" ::: "memory");
        } else {
            XB_SPIN(xb_ld(&bar[XB_XGEN(b.x)]) == gen, bar);
            __builtin_amdgcn_fence(__ATOMIC_ACQUIRE, "agent");
            asm volatile("s_waitcnt vmcnt(0)" ::: "memory");
        }
    }
    __syncthreads();
}

struct Frame {
    LAS unsigned char* lds;
    gu32* ctl;
    int tid, lane, wave, G, gw, NGW;
    unsigned char* ws;
};
__device__ __forceinline__ float wave_sum(float v) {
#pragma unroll
    for (int o = 1; o < 64; o <<= 1) v += __shfl_xor(v, o);
    return v;
}
__device__ __forceinline__ void transpose_item(const float* W, int K, int N, bf16* WT, int rs, int off, LAS float* scr, int item, int lane) {
    const int nblk = N / 32, kb = item / nblk, nb = item % nblk, k0 = 64 * kb, n0 = 32 * nb;
#pragma unroll 8
    for (int i = 0; i < 32; ++i) { const int kk = 2 * i + (lane >> 5); scr[kk * 33 + (lane & 31)] = W[(size_t)(k0 + kk) * N + n0 + (lane & 31)]; }
    LDS_WAIT(); asm volatile("" ::: "memory");
    const int c = lane & 7;
#pragma unroll
    for (int j = 0; j < 4; ++j) { const int n = (lane >> 3) + 8 * j; const LAS float* s = scr + (8 * c) * 33 + n;
        v4u o; o.x = pk2(s[0 * 33], s[1 * 33]); o.y = pk2(s[2 * 33], s[3 * 33]); o.z = pk2(s[4 * 33], s[5 * 33]); o.w = pk2(s[6 * 33], s[7 * 33]);
        const int ng = n0 + n, drow = (ng >> 7) * rs + (ng & 127) + off;
        *(v4u*)(WT + (size_t)drow * K + k0 + 8 * c) = o; }
    LDS_WAIT(); asm volatile("" ::: "memory");
}
#define NI(K_, N_) (((K_) / 64) * ((N_) / 32))
__device__ __forceinline__ void quant_slab(Frame& F, const float* W, int N, signed char* WT, float* sB, int rs, int off, int slab) {
    constexpr int PITCH = 1028;
    LAS unsigned char* Tt = F.lds; LAS float* red = (LAS float*)(F.lds + 64 * PITCH);
    const int w = F.wave, l = F.lane, g = l >> 4, c4 = l & 15, n0 = slab * 64, nc = n0 + 4 * c4;
    const bool live = nc < N;
    f32x4 v[8][4];
#pragma unroll
    for (int P = 0; P < 8; ++P)
#pragma unroll
        for (int j = 0; j < 4; ++j) { const int r = 128 * P + 16 * w + 4 * g + j; v[P][j] = live ? *(const f32x4*)(W + (size_t)r * N + nc) : (f32x4){0.f, 0.f, 0.f, 0.f}; }
    f32x4 mx = (f32x4){0.f, 0.f, 0.f, 0.f};
#pragma unroll
    for (int P = 0; P < 8; ++P)
#pragma unroll
        for (int j = 0; j < 4; ++j) { mx.x = fmaxf(mx.x, fabsf(v[P][j].x)); mx.y = fmaxf(mx.y, fabsf(v[P][j].y)); mx.z = fmaxf(mx.z, fabsf(v[P][j].z)); mx.w = fmaxf(mx.w, fabsf(v[P][j].w)); }
#pragma unroll
    for (int o = 16; o < 64; o <<= 1) { mx.x = fmaxf(mx.x, __shfl_xor(mx.x, o)); mx.y = fmaxf(mx.y, __shfl_xor(mx.y, o)); mx.z = fmaxf(mx.z, __shfl_xor(mx.z, o)); mx.w = fmaxf(mx.w, __shfl_xor(mx.w, o)); }
    if (g == 0) *(LAS f32x4*)(red + w * 64 + 4 * c4) = mx;
    __syncthreads();
#pragma unroll
    for (int ww = 0; ww < 8; ++ww) { const f32x4 t = *(const LAS f32x4*)(red + ww * 64 + 4 * c4); mx.x = fmaxf(mx.x, t.x); mx.y = fmaxf(mx.y, t.y); mx.z = fmaxf(mx.z, t.z); mx.w = fmaxf(mx.w, t.w); }
    f32x4 inv; inv.x = mx.x > 0.f ? 127.f / mx.x : 0.f; inv.y = mx.y > 0.f ? 127.f / mx.y : 0.f; inv.z = mx.z > 0.f ? 127.f / mx.z : 0.f; inv.w = mx.w > 0.f ? 127.f / mx.w : 0.f;
#pragma unroll
    for (int P = 0; P < 8; ++P) {
        unsigned wd[4];
#pragma unroll
        for (int i = 0; i < 4; ++i) { const float s = (i == 0) ? inv.x : (i == 1) ? inv.y : (i == 2) ? inv.z : inv.w;
            const int q0 = (int)__builtin_rintf(v[P][0][i] * s), q1 = (int)__builtin_rintf(v[P][1][i] * s), q2 = (int)__builtin_rintf(v[P][2][i] * s), q3 = (int)__builtin_rintf(v[P][3][i] * s);
            wd[i] = (unsigned)(q0 & 0xff) | ((unsigned)(q1 & 0xff) << 8) | ((unsigned)(q2 & 0xff) << 16) | ((unsigned)(q3 & 0xff) << 24); }
#pragma unroll
        for (int i = 0; i < 4; ++i) *(LAS unsigned*)(Tt + (4 * c4 + i) * PITCH + 128 * P + 16 * w + 4 * g) = wd[i];
    }
    if (w == 0 && g == 0 && live) {
#pragma unroll
        for (int i = 0; i < 4; ++i) { const int ng = nc + i, drow = (ng >> 7) * rs + (ng & 127) + off; sB[drow] = ((i == 0) ? mx.x : (i == 1) ? mx.y : (i == 2) ? mx.z : mx.w) * (1.f / 127.f); }
    }
    __syncthreads();
#pragma unroll
    for (int k = 0; k < 8; ++k) { const int n = 8 * w + k, ng = n0 + n;
        if (ng < N) { const LAS unsigned* sp = (const LAS unsigned*)(Tt + n * PITCH + 16 * l); const v4u o = (v4u){sp[0], sp[1], sp[2], sp[3]};
            const int drow = (ng >> 7) * rs + (ng & 127) + off; *((v4u*)(WT + (size_t)drow * D) + l) = o; } }
    __syncthreads();
}
__device__ __forceinline__ void quant_small(Frame& F, const float* const* in) {
    signed char* WB = (signed char*)(F.ws + WS_WSM); float* SB = (float*)(F.ws + WS_TAB + TAB_SB);
    constexpr int NSL = 2 * 20 + 48 + 11 + 4 * 44;
    for (int it = blockIdx.x; it < NSL; it += F.G) {
        int r = it; bool found = false; const float* W = nullptr; signed char* WT = nullptr; int N = 0, rs = 128, off = 0, so = 0;
#define JOB(Wp, WTp, N_, RS, OFF, SO) if (!found) { const int ni = ((N_) + 63) / 64; if (r < ni) { W = (Wp); WT = (WTp); N = (N_); rs = (RS); off = (OFF); so = (SO); found = true; } else r -= ni; }
        JOB(in[5], WB + B_SWAQKV, SWA_N, 128, 0, SBO_SWAQKV)
        JOB(in[5] + (size_t)D * SWA_N, WB + B_SWAQKV + (size_t)SWA_N * D, SWA_N, 128, 0, SBO_SWAQKV + SWA_N)
        JOB(in[9], WB + B_SBQKV, SB_N, 128, 0, SBO_SBQKV)
        JOB(in[11], WB + B_MLAD, 672, 128, 0, SBO_MLAD)
        JOB(in[17], WB + B_FFNGU, FFN, 256, 0, SBO_FFNGU)
        JOB(in[18], WB + B_FFNGU, FFN, 256, 128, SBO_FFNGU)
        JOB(in[17] + (size_t)D * FFN, WB + B_FFNGU + (size_t)2 * FFN * D, FFN, 256, 0, SBO_FFNGU + 2 * FFN)
        JOB(in[18] + (size_t)D * FFN, WB + B_FFNGU + (size_t)2 * FFN * D, FFN, 256, 128, SBO_FFNGU + 2 * FFN)
#undef JOB
        if (found) quant_slab(F, W, N, WT, SB + so, rs, off, r);
    }
}
__device__ __forceinline__ void quant_moe_gu(Frame& F, const float* wg, const float* wu, int f) {
    signed char* WM = (signed char*)(F.ws + WS_WMOE); float* SB = (float*)(F.ws + WS_TAB + TAB_SB) + SBO_MOE + f * 57344;
    constexpr int PER = EDIM / 64;
    for (int it = blockIdx.x; it < 16 * PER; it += F.G) {
        const int which = it / PER, r = it % PER, e = which >> 1, up = which & 1;
        quant_slab(F, (up ? wu : wg) + (size_t)e * D * EDIM, EDIM, WM + (size_t)e * B_MOEGU_E, SB + e * 7168, 256, up * 128, r);
    }
}
__device__ __forceinline__ void convert_small_bf16(Frame& F, const float* const* in) {
    LAS float* scr = (LAS float*)(F.lds + F.wave * 16384);
    unsigned char* WB = F.ws + WS_WSM;
    constexpr int NITEMS = 4 * NI(D, D) + NI(MLA_QR, MLA_UQN) + NI(MLA_KVR, MLA_UKVN) + 2 * NI(FFN, D);
    for (int it = F.gw; it < NITEMS; it += F.NGW) {
        int r = it; bool found = false; const float* W = nullptr; bf16* WT = nullptr; int K = 0, N = 0;
#define JOB(Wp, WTp, K_, N_) if (!found) { const int ni = NI(K_, N_); if (r < ni) { W = (Wp); WT = (bf16*)(WTp); K = (K_); N = (N_); found = true; } else r -= ni; }
        JOB(in[8], WB + B_SWAO, D, D)
        JOB(in[8] + (size_t)D * D, WB + B_SWAO + (size_t)D * D * 2, D, D)
        JOB(in[10], WB + B_SBO, D, D)
        JOB(in[16], WB + B_MLAO, D, D)
        JOB(in[13], WB + B_MLAUQ, MLA_QR, MLA_UQN)
        JOB(in[15], WB + B_MLAUKV, MLA_KVR, MLA_UKVN)
        JOB(in[19], WB + B_FFND, FFN, D)
        JOB(in[19] + (size_t)FFN * D, WB + B_FFND + (size_t)D * FFN * 2, FFN, D)
#undef JOB
        if (found) transpose_item(W, K, N, WT, 128, 0, scr, r, F.lane);
    }
    for (int i = F.gw * 64 + F.lane; i < SEQ * 16; i += F.NGW * 64) {
        const int pos = i >> 4, fi = i & 15;
        const double inv = exp2(-(double)fi * (13.287712379549449 / 16.0));
        const double turns = (double)pos * inv * 0.15915494309189535;
        const float fr = (float)(turns - floor(turns));
        ((float*)(F.ws + WS_TAB + TAB_COS))[i] = __builtin_amdgcn_cosf(fr);
        ((float*)(F.ws + WS_TAB + TAB_SIN))[i] = __builtin_amdgcn_sinf(fr);
    }
}
__device__ __forceinline__ void convert_moe_down(Frame& F, const float* wd) {
    LAS float* scr = (LAS float*)(F.lds + F.wave * 16384);
    constexpr int PER = NI(EDIM, D);
    for (int it = F.gw; it < 8 * PER; it += F.NGW) { const int e = it / PER, r = it % PER;
        transpose_item(wd + (size_t)e * EDIM * D, EDIM, D, (bf16*)(F.ws + WS_WMOE + B_MOED + (size_t)e * B_MOED_E), 128, 0, scr, r, F.lane); }
}
#undef NI
__device__ __forceinline__ void zero_mlad_pad(Frame& F) {
    for (int i = F.gw * 64 + F.lane; i < 96 * 1024 / 16; i += F.NGW * 64) *(v4u*)(F.ws + WS_WSM + B_MLAD + (size_t)672 * D + (size_t)i * 16) = (v4u){0u, 0u, 0u, 0u};
    float* SB = (float*)(F.ws + WS_TAB + TAB_SB) + SBO_MLAD;
    for (int i = F.gw * 64 + F.lane; i < 96; i += F.NGW * 64) SB[672 + i] = 0.f;
}
__device__ __forceinline__ void quant_row_store(const f32x4 (&v)[4], signed char* h8row, float* sa, int lane) {
    float mx = 0.f;
#pragma unroll
    for (int j = 0; j < 4; ++j) mx = fmaxf(mx, fmaxf(fmaxf(fabsf(v[j].x), fabsf(v[j].y)), fmaxf(fabsf(v[j].z), fabsf(v[j].w))));
#pragma unroll
    for (int o = 1; o < 64; o <<= 1) mx = fmaxf(mx, __shfl_xor(mx, o));
    const float inv = mx > 0.f ? 127.f / mx : 0.f;
    unsigned* o4 = (unsigned*)h8row + lane;
#pragma unroll
    for (int j = 0; j < 4; ++j) { const int q0 = (int)__builtin_rintf(v[j].x * inv), q1 = (int)__builtin_rintf(v[j].y * inv), q2 = (int)__builtin_rintf(v[j].z * inv), q3 = (int)__builtin_rintf(v[j].w * inv);
        o4[64 * j] = (unsigned)(q0 & 0xff) | ((unsigned)(q1 & 0xff) << 8) | ((unsigned)(q2 & 0xff) << 16) | ((unsigned)(q3 & 0xff) << 24); }
    if (lane == 0) *sa = mx * (1.f / 127.f);
}
__device__ __forceinline__ void norm_phase(Frame& F, const float* src, const bf16* delta, float* xout, const float* g, signed char* h8, float* sa) {
    f32x4 gv[4];
#pragma unroll
    for (int j = 0; j < 4; ++j) gv[j] = ((const f32x4*)g)[F.lane + 64 * j];
    for (int m = F.gw; m < T; m += F.NGW) {
        const f32x4* xr = (const f32x4*)(src + (size_t)m * D) + F.lane;
        f32x4 v[4]; float ss = 0.f;
#pragma unroll
        for (int j = 0; j < 4; ++j) v[j] = xr[64 * j];
        if (delta) { const v2u* dr = (const v2u*)(delta + (size_t)m * D) + F.lane; f32x4* xo = (f32x4*)(xout + (size_t)m * D) + F.lane;
#pragma unroll
            for (int j = 0; j < 4; ++j) { const v2u a = dr[64 * j]; v[j].x += bflo(a.x); v[j].y += bfhi(a.x); v[j].z += bflo(a.y); v[j].w += bfhi(a.y); xo[64 * j] = v[j]; } }
#pragma unroll
        for (int j = 0; j < 4; ++j) ss += (v[j].x * v[j].x + v[j].y * v[j].y) + (v[j].z * v[j].z + v[j].w * v[j].w);
        const float rstd = rsqrtf(wave_sum(ss) * (1.f / D) + RMS_EPS);
#pragma unroll
        for (int j = 0; j < 4; ++j) v[j] = v[j] * rstd * gv[j];
        quant_row_store(v, h8 + (size_t)m * D, sa + m, F.lane);
    }
}
__device__ __forceinline__ void norm_route_phase(Frame& F, float* src, const bf16* delta, const float* g, signed char* h8, float* sa, const float* router, int layer) {
    LAS float* Rt = (LAS float*)F.lds;
    for (int i = F.tid; i < D * NEXP; i += NWAVES * 64) { const int k = i >> 3, e = i & 7; Rt[e * D + k] = router[i]; }
    __syncthreads();
    f32x4 gv[4];
#pragma unroll
    for (int j = 0; j < 4; ++j) gv[j] = ((const f32x4*)g)[F.lane + 64 * j];
    int* tok_e = (int*)(F.ws + WS_TAB + TAB_TOKE); f32x2* tok_g = (f32x2*)(F.ws + WS_TAB + TAB_TOKG);
    unsigned long long cnt = 0ull;
    for (int m = F.gw; m < T; m += F.NGW) {
        f32x4* xr = (f32x4*)(src + (size_t)m * D) + F.lane;
        f32x4 v[4]; float ss = 0.f;
#pragma unroll
        for (int j = 0; j < 4; ++j) v[j] = xr[64 * j];
        if (delta) { const v2u* dr = (const v2u*)(delta + (size_t)m * D) + F.lane;
#pragma unroll
            for (int j = 0; j < 4; ++j) { const v2u a = dr[64 * j]; v[j].x += bflo(a.x); v[j].y += bfhi(a.x); v[j].z += bflo(a.y); v[j].w += bfhi(a.y); xr[64 * j] = v[j]; } }
#pragma unroll
        for (int j = 0; j < 4; ++j) ss += (v[j].x * v[j].x + v[j].y * v[j].y) + (v[j].z * v[j].z + v[j].w * v[j].w);
        const float rstd = rsqrtf(wave_sum(ss) * (1.f / D) + RMS_EPS);
#pragma unroll
        for (int j = 0; j < 4; ++j) v[j] = v[j] * rstd * gv[j];
        quant_row_store(v, h8 + (size_t)m * D, sa + m, F.lane);
        float lg[8];
#pragma unroll
        for (int e = 0; e < 8; ++e) { float a = 0.f;
#pragma unroll
            for (int j = 0; j < 4; ++j) { const f32x4 r = *(const LAS f32x4*)(Rt + e * D + 256 * j + 4 * F.lane); a += (v[j].x * r.x + v[j].y * r.y) + (v[j].z * r.z + v[j].w * r.w); }
            lg[e] = wave_sum(a); }
        int e1 = 0; float v1 = lg[0];
#pragma unroll
        for (int e = 1; e < 8; ++e) if (lg[e] > v1) { v1 = lg[e]; e1 = e; }
        int e2 = -1; float v2 = -3.0e38f;
#pragma unroll
        for (int e = 0; e < 8; ++e) if (e != e1 && lg[e] > v2) { v2 = lg[e]; e2 = e; }
        const float g1 = 1.f / (1.f + __expf(v2 - v1)), g2 = 1.f - g1;
        if (F.lane == 0) { tok_e[m] = e1 | (e2 << 8); tok_g[m] = (f32x2){g1, g2}; }
        cnt += (1ull << (8 * e1)) + (1ull << (8 * e2));
    }
    if (F.lane < 8) { const unsigned c = (unsigned)(cnt >> (8 * F.lane)) & 0xffu; if (c) __hip_atomic_fetch_add((unsigned*)(F.ctl + CW_CNT + 64 * layer) + F.lane, c, RLX_AGENT); }
    if (F.lane == 0) ((unsigned long long*)(F.ws + WS_TAB + TAB_WCNT))[layer * 4096 + F.gw] = cnt;
    __syncthreads();
}
struct MoeLayout { int poff[8]; int tp[9]; };
__device__ __forceinline__ MoeLayout moe_layout(Frame& F, int layer) {
    MoeLayout L; int acc = 0; L.tp[0] = 0;
#pragma unroll
    for (int e = 0; e < 8; ++e) { const int c = (int)__builtin_amdgcn_readfirstlane(__hip_atomic_load((unsigned*)(F.ctl + CW_CNT + 64 * layer) + e, RLX_AGENT)); L.poff[e] = acc * 256; acc += (c + 255) >> 8; L.tp[e + 1] = acc; }
    return L;
}
__device__ __forceinline__ void route_assign_phase(Frame& F, const signed char* h8, const float* sa, signed char* hperm, float* sap, int layer) {
    const MoeLayout L = moe_layout(F, layer);
    const int* tok_e = (const int*)(F.ws + WS_TAB + TAB_TOKE); int* tok_slot = (int*)(F.ws + WS_TAB + TAB_SLOT);
    const unsigned long long* wcnt = (const unsigned long long*)(F.ws + WS_TAB + TAB_WCNT) + layer * 4096;
    int base[8];
#pragma unroll
    for (int e = 0; e < 8; ++e) base[e] = 0;
    for (int g2 = F.lane; g2 < F.gw; g2 += 64) { const unsigned long long c = wcnt[g2];
#pragma unroll
        for (int e = 0; e < 8; ++e) base[e] += (int)((c >> (8 * e)) & 0xffull); }
#pragma unroll
    for (int e = 0; e < 8; ++e) { int v = base[e];
#pragma unroll
        for (int o = 1; o < 64; o <<= 1) v += __shfl_xor(v, o);
        base[e] = L.poff[e] + v; }
    const int nmine = (T - F.gw + F.NGW - 1) / F.NGW;
    for (int k0 = 0; k0 < nmine; k0 += 16) {
        const int kk = k0 + (F.lane & 15), k = (F.lane >> 4) & 1;
        const bool act = F.lane < 32 && kk < nmine;
        const int tok = act ? F.gw + kk * F.NGW : 0;
        int my_e = 255;
        if (act) my_e = (tok_e[tok] >> (8 * k)) & 0xff;
        int slot = 0;
#pragma unroll
        for (int e = 0; e < 8; ++e) {
            const unsigned long long m1 = __ballot(my_e == e);
            const unsigned lo = (unsigned)m1 & 0xffffu, hi = ((unsigned)m1 >> 16) & 0xffffu;
            const unsigned r = F.lane & 15, below = (1u << r) - 1u;
            const int rank = __popc(lo & below) + __popc(hi & below);
            if (my_e == e) slot = base[e] + rank;
            base[e] += __popc(lo) + __popc(hi);
        }
        if (act) { tok_slot[tok * 2 + k] = slot; sap[slot] = sa[tok]; }
#pragma unroll 8
        for (int j = 0; j < 32; ++j) {
            const int tj = __shfl(tok, j), sj = __shfl(slot, j), aj = __shfl((int)act, j);
            if (aj) *((v4u*)(hperm + (size_t)sj * D) + F.lane) = *((const v4u*)(h8 + (size_t)tj * D) + F.lane);
        }
    }
}
template <bool FINAL>
__device__ __forceinline__ void combine_norm_phase(Frame& F, float* xres, const bf16* y, const float* g, signed char* h8, float* sa) {
    const bf16* yp = (const bf16*)(F.ws + WS_YP);
    f32x4 gv[4];
#pragma unroll
    for (int j = 0; j < 4; ++j) gv[j] = ((const f32x4*)g)[F.lane + 64 * j];
    const i32x2* tok_slot = (const i32x2*)(F.ws + WS_TAB + TAB_SLOT); const f32x2* tok_g = (const f32x2*)(F.ws + WS_TAB + TAB_TOKG);
    for (int m = F.gw; m < T; m += F.NGW) {
        const i32x2 sl = tok_slot[m]; const f32x2 gg = tok_g[m];
        f32x4* xr = (f32x4*)(xres + (size_t)m * D) + F.lane;
        f32x4 v[4]; float ss = 0.f;
#pragma unroll
        for (int j = 0; j < 4; ++j) v[j] = xr[64 * j];
#pragma unroll
        for (int k = 0; k < 2; ++k) { const int slot = k ? sl.y : sl.x; const float gk = k ? gg.y : gg.x;
            if (slot < 65536) { const v2u* yr = (const v2u*)(y + (size_t)slot * D) + F.lane;
#pragma unroll
                for (int j = 0; j < 4; ++j) { const v2u a = yr[64 * j]; v[j].x += gk * bflo(a.x); v[j].y += gk * bfhi(a.x); v[j].z += gk * bflo(a.y); v[j].w += gk * bfhi(a.y); } }
            else { f32x4 t[4];
#pragma unroll
                for (int j = 0; j < 4; ++j) t[j] = (f32x4){0.f, 0.f, 0.f, 0.f};
                for (int p = 0; p < 7; ++p) { const v2u* yr = (const v2u*)(yp + (size_t)p * YP_ELEMS + (size_t)(slot - 65536) * D) + F.lane;
#pragma unroll
                    for (int j = 0; j < 4; ++j) { const v2u a = yr[64 * j]; t[j].x += bflo(a.x); t[j].y += bfhi(a.x); t[j].z += bflo(a.y); t[j].w += bfhi(a.y); } }
#pragma unroll
                for (int j = 0; j < 4; ++j) v[j] = v[j] + t[j] * gk; } }
#pragma unroll
        for (int j = 0; j < 4; ++j) ss += (v[j].x * v[j].x + v[j].y * v[j].y) + (v[j].z * v[j].z + v[j].w * v[j].w);
        const float rstd = rsqrtf(wave_sum(ss) * (1.f / D) + RMS_EPS);
        if (FINAL) {
#pragma unroll
            for (int j = 0; j < 4; ++j) xr[64 * j] = v[j] * rstd * gv[j];
        } else {
#pragma unroll
            for (int j = 0; j < 4; ++j) { xr[64 * j] = v[j]; v[j] = v[j] * rstd * gv[j]; }
            quant_row_store(v, h8 + (size_t)m * D, sa + m, F.lane);
        }
    }
}
__device__ __forceinline__ void mla_cnorm_phase(Frame& F, const bf16* c, const float* qn, const float* kvn, bf16* cqn, bf16* ckvn, bf16* krope) {
    const float* cosT = (const float*)(F.ws + WS_TAB + TAB_COS); const float* sinT = (const float*)(F.ws + WS_TAB + TAB_SIN);
    float gq[6], gk[4];
#pragma unroll
    for (int j = 0; j < 6; ++j) gq[j] = qn[F.lane + 64 * j];
#pragma unroll
    for (int j = 0; j < 4; ++j) gk[j] = kvn[F.lane + 64 * j];
    for (int m = F.gw; m < T; m += F.NGW) {
        const bf16* cr = c + (size_t)m * MLA_DN;
        float a[6], b[4]; float sa = 0.f, sb = 0.f;
#pragma unroll
        for (int j = 0; j < 6; ++j) { a[j] = bflo((unsigned)cr[F.lane + 64 * j]); sa += a[j] * a[j]; }
#pragma unroll
        for (int j = 0; j < 4; ++j) { b[j] = bflo((unsigned)cr[MLA_QR + F.lane + 64 * j]); sb += b[j] * b[j]; }
        const float kr = bflo((unsigned)cr[MLA_QR + MLA_KVR + (F.lane & 31)]);
        const float ra = rsqrtf(wave_sum(sa) * (1.f / MLA_QR) + RMS_EPS), rb = rsqrtf(wave_sum(sb) * (1.f / MLA_KVR) + RMS_EPS);
#pragma unroll
        for (int j = 0; j < 6; ++j) cqn[(size_t)m * MLA_QR + F.lane + 64 * j] = (bf16)f2bf(a[j] * ra * gq[j]);
#pragma unroll
        for (int j = 0; j < 4; ++j) ckvn[(size_t)m * MLA_KVR + F.lane + 64 * j] = (bf16)f2bf(b[j] * rb * gk[j]);
        const float pr = __shfl_xor(kr, 16);
        const int pos = m & (SEQ - 1), i = F.lane & 15; const float cs = cosT[pos * 16 + i], sn = sinT[pos * 16 + i];
        const float ro = ((F.lane & 16) == 0) ? kr * cs - pr * sn : pr * sn + kr * cs;
        if (F.lane < 32) krope[(size_t)m * 32 + F.lane] = (bf16)f2bf(ro);
    }
}

struct Args { const float* in[24]; float* out; unsigned char* ws; int ph_lo, ph_hi; };
constexpr int LDS_BYTES = 147456, RING_BYTES = 131072, MISC_OFF = RING_BYTES + 320;

__global__ void __launch_bounds__(NWAVES * 64, 2) trunk_fwd(Args args) {
    extern __shared__ __attribute__((aligned(16))) unsigned char lds[];
    Frame F;
    F.lds = (LAS unsigned char*)lds; F.ws = args.ws; F.ctl = (gu32*)(args.ws + WS_CTL);
    F.tid = threadIdx.x; F.lane = F.tid & 63; F.wave = __builtin_amdgcn_readfirstlane(F.tid >> 6); F.G = gridDim.x;
    F.gw = blockIdx.x * NWAVES + F.wave; F.NGW = F.G * NWAVES;
    volatile LAS unsigned* MISC = (volatile LAS unsigned*)(F.lds + MISC_OFF);
    for (int u = F.tid; u < (LDS_BYTES - RING_BYTES) / 4; u += NWAVES * 64) ((LAS unsigned*)(F.lds + RING_BYTES))[u] = 0u;
    __syncthreads();
    const int lo = args.ph_lo, hi = args.ph_hi;
    XcdBarrier bar; bar.bar = (unsigned*)(F.ctl + CW_BAR); bar.x = 0; bar.st = nullptr;
    if (hi - lo > 1) bar = xcd_barrier_post((unsigned*)(F.ctl + CW_BAR), MISC + 8);
#define IN(k) (lo <= (k) && (k) < hi)
#define RUN(k) if (IN(k)) _Pragma("unroll") for (int rep_ = 0; rep_ < ((((k) == PROBE_A) || ((k) == PROBE_B) || ((k) == PROBE_C)) ? 2 : 1); ++rep_)
#define SEAM(k) do { if (IN(k) && IN((k) + 1)) xcd_barrier(bar); } while (0)
    const float* const* in = args.in;
    unsigned char* ws = args.ws;
    float* xres = args.out;
    unsigned char* WB = ws + WS_WSM; unsigned char* WM = ws + WS_WMOE;
    bf16* H = (bf16*)(ws + WS_H); signed char* H8 = (signed char*)(ws + WS_H);
    float* SA = (float*)(ws + WS_TAB + TAB_SA); float* SAP = (float*)(ws + WS_TAB + TAB_SAP); const float* SB = (const float*)(ws + WS_TAB + TAB_SB);
    unsigned char* scr = ws + WS_SCR; bf16* DELTA = (bf16*)(scr + SC_DELTA);
    const float* cosT = (const float*)(ws + WS_TAB + TAB_COS); const float* sinT = (const float*)(ws + WS_TAB + TAB_SIN);
    LAS unsigned char* ring = F.lds;
    const int c = (int)blockIdx.x;

#define GEMM_BF16S_I8(Btp, N_, Op, ldc_, biasp, nsc_, sc_, sbo_) do { pg8::Gemm g{(const pg8::bf16_t*)H8, (const pg8::bf16_t*)(Btp), T, (N_), D, D}; pg8::StaticOrder S; S.init(T, (N_), F.G, c); \
        pg8::EpiBf16S E{(pg8::bf16_t*)(Op), (ldc_), (biasp), (nsc_), (sc_), SA, SB + (sbo_)}; pg8::gemm_phase<pg8::EpiBf16S, pg8::StaticOrder, true, true, true>(ring, g, S, E); } while (0)
#define GEMM_BF16S(Ap, Btp, M_, N_, K_, Op, ldc_, nsc_, sc_) do { pg8::Gemm g{(const pg8::bf16_t*)(Ap), (const pg8::bf16_t*)(Btp), (M_), (N_), (K_), (K_)}; pg8::StaticOrder S; S.init((M_), (N_), F.G, c); \
        pg8::EpiBf16S E{(pg8::bf16_t*)(Op), (ldc_), nullptr, (nsc_), (sc_), nullptr, nullptr}; pg8::gemm_phase<pg8::EpiBf16S, pg8::StaticOrder, true, true, false>(ring, g, S, E); } while (0)
#define GEMM_RES(Ap, Btp, K_, basep) do { pg8::Gemm g{(const pg8::bf16_t*)(Ap), (const pg8::bf16_t*)(Btp), T, D, (K_), (K_)}; pg8::StaticOrder S; S.init(T, D, F.G, c); \
        pg8::EpiResF32 E{(basep), xres, D}; pg8::gemm_phase<pg8::EpiResF32, pg8::StaticOrder, true, true, false>(ring, g, S, E); } while (0)
#define GEMM_SWIGLU_I8(Btp, N2_, Op, sbo_) do { pg8::Gemm g{(const pg8::bf16_t*)H8, (const pg8::bf16_t*)(Btp), T, (N2_), D, D}; pg8::StaticOrder S; S.init(T, (N2_), F.G, c); \
        pg8::EpiSwiGLU E{(pg8::bf16_t*)(Op), (N2_) / 2, SA, SB + (sbo_)}; pg8::gemm_phase<pg8::EpiSwiGLU, pg8::StaticOrder, true, true, true>(ring, g, S, E); } while (0)
#define ATTN(MODE_, AA) do { if ((NAIVE_ATTN >> (MODE_)) & 1) att::attn_naive<MODE_>(AA, F.G, c); else att::attn_phase<MODE_>((LAS char*)ring, AA, F.G, c); } while (0)
#define MOE_GEMMS(layer_, k1, k2) \
    RUN(k1) { const MoeLayout ML = moe_layout(F, (layer_)); pg8::Gemm g{(const pg8::bf16_t*)(scr + SC_HPERM), (const pg8::bf16_t*)WM, PMAX, 2 * EDIM, D, D}; \
        pg8::GroupedOrder S; S.nM = ML.tp[8]; S.nN = 2 * EDIM / 256; S.nwg = S.nM * S.nN; S.G = F.G; S.c = c; S.tp1 = ML.tp[1]; S.tp2 = ML.tp[2]; S.tp3 = ML.tp[3]; S.tp4 = ML.tp[4]; S.tp5 = ML.tp[5]; S.tp6 = ML.tp[6]; S.tp7 = ML.tp[7]; S.estride = (long)B_MOEGU_E; S.sstride = 2 * EDIM; \
        pg8::EpiSwiGLU E{(pg8::bf16_t*)(scr + SC_MACT), EDIM, SAP, SB + SBO_MOE + (layer_) * 57344}; pg8::gemm_phase<pg8::EpiSwiGLU, pg8::GroupedOrder, true, true, true>(ring, g, S, E); } \
    SEAM(k1); \
    RUN(k2) { const MoeLayout ML = moe_layout(F, (layer_)); \
        { pg8::Gemm g{(const pg8::bf16_t*)(scr + SC_MACT), (const pg8::bf16_t*)(WM + B_MOED), PMAX, D, EDIM, EDIM}; \
          pg8::GroupedOrder S; S.nM = ML.tp[8] < 256 ? ML.tp[8] : 256; S.nN = D / 256; S.nwg = S.nM * S.nN; S.G = F.G; S.c = c; S.tp1 = ML.tp[1]; S.tp2 = ML.tp[2]; S.tp3 = ML.tp[3]; S.tp4 = ML.tp[4]; S.tp5 = ML.tp[5]; S.tp6 = ML.tp[6]; S.tp7 = ML.tp[7]; S.estride = (long)B_MOED_E; S.sstride = 0; \
          pg8::EpiBf16S E{(pg8::bf16_t*)(scr + SC_HPERM), D, nullptr, 0, 1.f, nullptr, nullptr}; pg8::gemm_phase<pg8::EpiBf16S, pg8::GroupedOrder, true, true, false>(ring, g, S, E); } \
        if (ML.tp[8] > 256) { pg8::Gemm g{(const pg8::bf16_t*)(scr + SC_MACT), (const pg8::bf16_t*)(WM + B_MOED), PMAX, D, 512, EDIM}; \
          pg8::SplitKOrder S; S.nrem = ML.tp[8] - 256; S.G = F.G; S.c = c; S.tp1 = ML.tp[1]; S.tp2 = ML.tp[2]; S.tp3 = ML.tp[3]; S.tp4 = ML.tp[4]; S.tp5 = ML.tp[5]; S.tp6 = ML.tp[6]; S.tp7 = ML.tp[7]; S.estride = (long)B_MOED_E; S.pstride = (long)YP_ELEMS; \
          pg8::EpiBf16S E{(pg8::bf16_t*)(ws + WS_YP), D, nullptr, 0, 1.f, nullptr, nullptr}; pg8::gemm_phase<pg8::EpiBf16S, pg8::SplitKOrder, true, true, false>(ring, g, S, E); } } \
    SEAM(k2);

    RUN(0) { quant_small(F, in); quant_moe_gu(F, in[21], in[22], 0); convert_small_bf16(F, in); convert_moe_down(F, in[23]); zero_mlad_pad(F); norm_phase(F, in[0], nullptr, nullptr, in[2], H8, SA); }
    SEAM(0);
    RUN(2) GEMM_BF16S_I8(WB + B_SWAQKV, SWA_N, scr + SC_QKV, SWA_N, in[6], 4, 0.125f * LOG2E, SBO_SWAQKV);
    SEAM(2);
    RUN(3) { const bf16* QKV = (const bf16*)(scr + SC_QKV); att::Args A{QKV, SWA_N, 64, QKV + 1024, SWA_N, 64, nullptr, QKV + 1152, SWA_N, 64, H, cosT, sinT, in[1], in[7]}; ATTN(0, A); }
    SEAM(3);
    RUN(4) GEMM_RES(H, WB + B_SWAO, D, in[0]);
    SEAM(4);
    RUN(5) norm_phase(F, xres, nullptr, nullptr, in[3], H8, SA);
    SEAM(5);
    RUN(6) GEMM_SWIGLU_I8(WB + B_FFNGU, 2 * FFN, scr + SC_ACT, SBO_FFNGU);
    SEAM(6);
    RUN(7) GEMM_RES(scr + SC_ACT, WB + B_FFND, FFN, xres);
    SEAM(7);
    RUN(8) norm_phase(F, xres, nullptr, nullptr, in[2] + D, H8, SA);
    SEAM(8);
    RUN(9) GEMM_BF16S_I8(WB + B_SBQKV, SB_N, scr + SC_QKV, SB_N, nullptr, 4, 0.125f * LOG2E, SBO_SBQKV);
    SEAM(9);
    RUN(10) { const bf16* QKV = (const bf16*)(scr + SC_QKV); att::Args A{QKV, SB_N, 64, QKV + 1024, SB_N, 64, nullptr, QKV + 2048, SB_N, 64, H, cosT, sinT, in[1], in[7]}; ATTN(1, A); }
    SEAM(10);
    RUN(11) GEMM_RES(H, WB + B_SBO, D, xres);
    SEAM(11);
    RUN(12) norm_route_phase(F, xres, nullptr, in[3] + D, H8, SA, in[20], 0);
    SEAM(12);
    RUN(13) route_assign_phase(F, H8, SA, (signed char*)(scr + SC_HPERM), SAP, 0);
    SEAM(13);
    MOE_GEMMS(0, 14, 15)
    RUN(16) { combine_norm_phase<false>(F, xres, (const bf16*)(scr + SC_HPERM), in[2] + 2 * D, H8, SA);
              quant_moe_gu(F, in[21] + (size_t)8 * D * EDIM, in[22] + (size_t)8 * D * EDIM, 1); convert_moe_down(F, in[23] + (size_t)8 * EDIM * D); }
    SEAM(16);
    RUN(17) GEMM_BF16S_I8(WB + B_MLAD, MLA_DN, scr + SC_C, MLA_DN, nullptr, 0, 1.f, SBO_MLAD);
    SEAM(17);
    RUN(18) mla_cnorm_phase(F, (const bf16*)(scr + SC_C), in[12], in[14], (bf16*)(scr + SC_CQN), (bf16*)(scr + SC_CKVN), (bf16*)(scr + SC_KROPE));
    SEAM(18);
    RUN(19) { GEMM_BF16S(scr + SC_CQN, WB + B_MLAUQ, T, MLA_UQN, MLA_QR, scr + SC_QM, MLA_UQN, 6, 0.10206207261596577f * LOG2E);
              GEMM_BF16S(scr + SC_CKVN, WB + B_MLAUKV, T, MLA_UKVN, MLA_KVR, scr + SC_KVM, MLA_UKVN, 0, 1.f); }
    SEAM(19);
    RUN(20) { const bf16* KV = (const bf16*)(scr + SC_KVM); att::Args A{(const bf16*)(scr + SC_QM), MLA_UQN, 96, KV, MLA_UKVN, 128, (const bf16*)(scr + SC_KROPE), KV + 64, MLA_UKVN, 128, H, cosT, sinT, in[1], in[7]}; ATTN(2, A); }
    SEAM(20);
    RUN(21) GEMM_RES(H, WB + B_MLAO, D, xres);
    SEAM(21);
    RUN(22) norm_phase(F, xres, nullptr, nullptr, in[3] + 2 * D, H8, SA);
    SEAM(22);
    RUN(23) GEMM_SWIGLU_I8(WB + B_FFNGU + (size_t)2 * FFN * D, 2 * FFN, scr + SC_ACT, SBO_FFNGU + 2 * FFN);
    SEAM(23);
    RUN(24) GEMM_RES(scr + SC_ACT, WB + B_FFND + (size_t)D * FFN * 2, FFN, xres);
    SEAM(24);
    RUN(25) norm_phase(F, xres, nullptr, nullptr, in[2] + 3 * D, H8, SA);
    SEAM(25);
    RUN(26) GEMM_BF16S_I8(WB + B_SWAQKV + (size_t)SWA_N * D, SWA_N, scr + SC_QKV, SWA_N, in[6] + SWA_N, 4, 0.125f * LOG2E, SBO_SWAQKV + SWA_N);
    SEAM(26);
    RUN(27) { const bf16* QKV = (const bf16*)(scr + SC_QKV); att::Args A{QKV, SWA_N, 64, QKV + 1024, SWA_N, 64, nullptr, QKV + 1152, SWA_N, 64, H, cosT, sinT, in[1], in[7] + 16}; ATTN(0, A); }
    SEAM(27);
    RUN(28) GEMM_RES(H, WB + B_SWAO + (size_t)D * D * 2, D, xres);
    SEAM(28);
    RUN(29) norm_route_phase(F, xres, nullptr, in[3] + 3 * D, H8, SA, in[20] + D * NEXP, 1);
    SEAM(29);
    RUN(30) route_assign_phase(F, H8, SA, (signed char*)(scr + SC_HPERM), SAP, 1);
    SEAM(30);
    MOE_GEMMS(1, 31, 32)
    RUN(33) combine_norm_phase<true>(F, xres, (const bf16*)(scr + SC_HPERM), in[4], nullptr, nullptr);
#undef IN
#undef RUN
#undef SEAM
}

extern "C" void kernel_launch(void* const* d_in, const int* in_sizes, int n_in, void* d_out, int out_size, void* d_ws, size_t ws_size, hipStream_t stream) {
    static int grid = 0;
    if (grid == 0) {
        if (n_in != 24 || in_sizes[0] != T * D || out_size != T * D || ws_size < WS_END) { fprintf(stderr, "kernel_launch: unexpected problem (n_in %d, in0 %d, out %d, ws %zu < %zu); nothing launched\n", n_in, n_in > 0 ? in_sizes[0] : -1, out_size, ws_size, (size_t)WS_END); grid = -1; return; }
        int dev = 0, cus = 0, per_cu = 0;
        if (hipGetDevice(&dev) != hipSuccess || hipDeviceGetAttribute(&cus, hipDeviceAttributeMultiprocessorCount, dev) != hipSuccess) { grid = -1; return; }
        if (hipFuncSetAttribute((const void*)trunk_fwd, hipFuncAttributeMaxDynamicSharedMemorySize, LDS_BYTES) != hipSuccess) { fprintf(stderr, "kernel_launch: hipFuncSetAttribute failed\n"); grid = -1; return; }
        if (hipOccupancyMaxActiveBlocksPerMultiprocessor(&per_cu, (const void*)trunk_fwd, NWAVES * 64, LDS_BYTES) != hipSuccess || per_cu < 1) { fprintf(stderr, "kernel_launch: occupancy query reports %d blocks per CU\n", per_cu); }
        (void)hipGetLastError();
        grid = cus;
    }
    if (grid < 0) return;
    if (hipMemsetAsync((char*)d_ws + WS_CTL, 0, CTL_ZERO_BYTES, stream) != hipSuccess) return;
    Args a{};
    for (int i = 0; i < 24; ++i) a.in[i] = (const float*)d_in[i];
    a.out = (float*)d_out; a.ws = (unsigned char*)d_ws;
#if MK_PER_PHASE
    for (int p = 0; p < NPH; ++p) { a.ph_lo = p; a.ph_hi = p + 1; hipLaunchKernelGGL(trunk_fwd, dim3(grid), dim3(NWAVES * 64), LDS_BYTES, stream, a); }
#else
    a.ph_lo = 0; a.ph_hi = NPH;
    hipLaunchKernelGGL(trunk_fwd, dim3(grid), dim3(NWAVES * 64), LDS_BYTES, stream, a);
#endif
    const hipError_t le = hipPeekAtLastError();
    if (le != hipSuccess) fprintf(stderr, "kernel_launch: launch failed: %s\n", hipGetErrorName(le));
}
```

```cpp
#include <hip/hip_runtime.h>
#include <cstdio>
#include <cstdint>

#ifndef MK_PER_PHASE
#define MK_PER_PHASE 0
#endif
#ifndef NAIVE_ATTN
#define NAIVE_ATTN 0
#endif

#ifndef PROBE_A
#define PROBE_A -1
#endif
#ifndef PROBE_B
#define PROBE_B -1
#endif
#ifndef PROBE_C
#define PROBE_C -1
#endif
#define GAS __attribute__((address_space(1)))
#define LAS __attribute__((address_space(3)))

namespace pg8 {
#define PG8_LAS __attribute__((address_space(3)))
typedef unsigned short bf16_t;
typedef short bf16x8 __attribute__((ext_vector_type(8)));
typedef float f32x4 __attribute__((ext_vector_type(4)));
typedef float f32x2 __attribute__((ext_vector_type(2)));
typedef unsigned u32x4 __attribute__((ext_vector_type(4)));
constexpr int BM = 256, BK = 64, HALF = 128, HTB = HALF * BK * 2  , STAGE_BYTES = 8 * HTB, NXCD = 8, WGM = 8;

__host__ __device__ __forceinline__ int lds_byte(int r, int c) { const int st = (r >> 4) * 2 + (c >> 5), rr = r & 15, cc = c & 31, ob = rr * 64 + cc * 2; return st * 1024 + (ob ^ (((ob >> 9) & 1) << 5)); }
__host__ __device__ __forceinline__ void stage_rc(int b, int& R, int& C) { const int st = b / 1024, sb = b % 1024, swz = sb ^ (((sb >> 9) & 1) << 5); R = (st >> 1) * 16 + swz / 64; C = (st & 1) * 32 + (swz % 64) / 2; }
__host__ __device__ __forceinline__ int perm32(int rho) { const int n = rho >> 4, i = rho & 15; return 8 * (i >> 2) + 4 * n + (i & 3); }

struct Unit { int pm, pn; long bo; int so; long ao, oo; };
typedef int i32x4 __attribute__((ext_vector_type(4)));
template <bool I8> struct AccSel { typedef f32x4 type; };
template <> struct AccSel<true> { typedef i32x4 type; };
template <class T> struct IsI8 { static constexpr bool v = false; };
template <> struct IsI8<i32x4> { static constexpr bool v = true; };
__device__ __forceinline__ void mma16(f32x4& c, bf16x8 b, bf16x8 a) { c = __builtin_amdgcn_mfma_f32_16x16x32_bf16(b, a, c, 0, 0, 0); }
__device__ __forceinline__ void mma16(i32x4& c, bf16x8 b, bf16x8 a) { c = __builtin_amdgcn_mfma_i32_16x16x64_i8(__builtin_bit_cast(i32x4, b), __builtin_bit_cast(i32x4, a), c, 0, 0, 0); }
__device__ __forceinline__ f32x4 accval(const f32x4& a, float, const f32x4&) { return a; }
__device__ __forceinline__ f32x4 accval(const i32x4& a, float sa, const f32x4& sb) { return __builtin_convertvector(a, f32x4) * (sb * sa); }
struct Gemm { const bf16_t* A; const bf16_t* Bt; int M, N, K, ld; };

struct StaticOrder {
    int nM, nN, nwg, G, c;
    __device__ void init(int M, int N, int G_, int c_) { nM = M / BM; nN = N / BM; nwg = nM * nN; G = G_; c = c_; }
    __device__ bool next(int i, Unit& u) const {
        const long L = (long)i * G + c; if (L >= nwg) return false;
        int wgid = (int)L; { const int q = nwg / NXCD, r = nwg % NXCD, xcd = wgid % NXCD, off = wgid / NXCD; wgid = (xcd < r ? xcd * (q + 1) : r * (q + 1) + (xcd - r) * q) + off; }
        const int nig = WGM * nN, gid = wgid / nig, fm = gid * WGM, gsz = (nM - fm) < WGM ? (nM - fm) : WGM;
        u.pm = fm + ((wgid % nig) % gsz); u.pn = (wgid % nig) / gsz; u.bo = 0; u.so = 0; u.ao = 0; u.oo = 0; return true;
    }
    __device__ __forceinline__ void a_ready(const Unit&) const {}
    __device__ __forceinline__ void done(const Unit&) const {}
};
struct GroupedOrder {
    int nM, nN, nwg, G, c; int tp1, tp2, tp3, tp4, tp5, tp6, tp7; long estride; int sstride;
    __device__ bool next(int i, Unit& u) const {
        const long L = (long)i * G + c; if (L >= nwg) return false;
        int wgid = (int)L; { const int q = nwg / NXCD, r = nwg % NXCD, xcd = wgid % NXCD, off = wgid / NXCD; wgid = (xcd < r ? xcd * (q + 1) : r * (q + 1) + (xcd - r) * q) + off; }
        const int nig = WGM * nN, gid = wgid / nig, fm = gid * WGM, gsz = (nM - fm) < WGM ? (nM - fm) : WGM;
        u.pm = fm + ((wgid % nig) % gsz); u.pn = (wgid % nig) / gsz;
        const int e = (u.pm >= tp1) + (u.pm >= tp2) + (u.pm >= tp3) + (u.pm >= tp4) + (u.pm >= tp5) + (u.pm >= tp6) + (u.pm >= tp7);
        u.bo = (long)e * estride; u.so = e * sstride; u.ao = 0; u.oo = 0; return true;
    }
    __device__ __forceinline__ void a_ready(const Unit&) const {}
    __device__ __forceinline__ void done(const Unit&) const {}
};

struct SplitKOrder {
    int nrem, G, c; int tp1, tp2, tp3, tp4, tp5, tp6, tp7; long estride; long pstride;
    __device__ bool next(int i, Unit& u) const {
        const long L = (long)i * G + c; if (L >= (long)nrem * 28) return false;
        const int p = (int)L % 7, un = (int)L / 7; u.pn = un & 3; u.pm = 256 + (un >> 2);
        const int e = (u.pm >= tp1) + (u.pm >= tp2) + (u.pm >= tp3) + (u.pm >= tp4) + (u.pm >= tp5) + (u.pm >= tp6) + (u.pm >= tp7);
        u.bo = (long)e * estride + (long)p * 1024; u.ao = (long)p * 1024; u.so = 0; u.oo = (long)p * pstride - (long)65536 * 1024; return true;
    }
    __device__ __forceinline__ void a_ready(const Unit&) const {}
    __device__ __forceinline__ void done(const Unit&) const {}
};

__device__ __forceinline__ unsigned cvt_pk_bf16(float lo, float hi) { unsigned r; asm volatile("v_cvt_pk_bf16_f32 %0, %1, %2" : "=v"(r) : "v"(lo), "v"(hi)); return r; }

struct EpiBf16S {
    static constexpr bool PERM = true, AFTER_DRAIN = false;
    bf16_t* O; int ldc; const float* bias; int nsc; float sc; const float* sA; const float* sB;
    template <class AccT>
    __device__ __forceinline__ void operator()(const AccT (&acc)[2][2][4][2], const Unit& u, int wr, int wc, int fr, int fq) const {
        constexpr bool I8 = IsI8<AccT>::v;
        const int row0 = u.pm * BM + wr * 64 + fr, col0 = u.pn * BM + wc * 32 + 8 * fq;
        const float s = (u.pn < nsc) ? sc : 1.f;
        f32x4 bv[2][2], sb[2][2];
#pragma unroll
        for (int bj = 0; bj < 2; ++bj)
#pragma unroll
            for (int n = 0; n < 2; ++n) sb[bj][n] = I8 ? *(const f32x4*)(sB + u.so + col0 + bj * HALF + 4 * n) : (f32x4){1.f, 1.f, 1.f, 1.f};
#pragma unroll
        for (int bj = 0; bj < 2; ++bj)
#pragma unroll
            for (int n = 0; n < 2; ++n) bv[bj][n] = bias ? *(const f32x4*)(bias + col0 + bj * HALF + 4 * n) : (f32x4){0.f, 0.f, 0.f, 0.f};
        float sav[2][4];
#pragma unroll
        for (int ai = 0; ai < 2; ++ai)
#pragma unroll
            for (int m = 0; m < 4; ++m) sav[ai][m] = I8 ? sA[row0 + ai * HALF + m * 16] : 1.f;
        asm volatile("" : "+v"(sav[0][0]), "+v"(sav[0][1]), "+v"(sav[0][2]), "+v"(sav[0][3]), "+v"(sav[1][0]), "+v"(sav[1][1]), "+v"(sav[1][2]), "+v"(sav[1][3]));
#pragma unroll
        for (int ai = 0; ai < 2; ++ai)
#pragma unroll
            for (int m = 0; m < 4; ++m) { bf16_t* rowp = O + u.oo + (size_t)(row0 + ai * HALF + m * 16) * ldc + col0;
                const float sa = sav[ai][m];
#pragma unroll
                for (int bj = 0; bj < 2; ++bj) { f32x4 v0 = (accval(acc[ai][bj][m][0], sa, sb[bj][0]) + bv[bj][0]) * s, v1 = (accval(acc[ai][bj][m][1], sa, sb[bj][1]) + bv[bj][1]) * s;
                    u32x4 w; w.x = cvt_pk_bf16(v0[0], v0[1]); w.y = cvt_pk_bf16(v0[2], v0[3]); w.z = cvt_pk_bf16(v1[0], v1[1]); w.w = cvt_pk_bf16(v1[2], v1[3]);
                    *(u32x4*)(rowp + bj * HALF) = w; } }
    }
};
__device__ __forceinline__ float silu_mul(float g, float u) { return g * u * __builtin_amdgcn_rcpf(1.f + __builtin_amdgcn_exp2f(-1.4426950408889634f * g)); }
struct EpiSwiGLU {
    static constexpr bool PERM = true, AFTER_DRAIN = false;
    bf16_t* O; int ldc; const float* sA; const float* sB;
    template <class AccT>
    __device__ __forceinline__ void operator()(const AccT (&acc)[2][2][4][2], const Unit& u, int wr, int wc, int fr, int fq) const {
        constexpr bool I8 = IsI8<AccT>::v;
        const int row0 = u.pm * BM + wr * 64 + fr, col0 = u.pn * HALF + wc * 32 + 8 * fq, colb = u.pn * BM + wc * 32 + 8 * fq;
        f32x4 sb[2][2];
#pragma unroll
        for (int bj = 0; bj < 2; ++bj)
#pragma unroll
            for (int n = 0; n < 2; ++n) sb[bj][n] = I8 ? *(const f32x4*)(sB + u.so + colb + bj * HALF + 4 * n) : (f32x4){1.f, 1.f, 1.f, 1.f};
        float sav[2][4];
#pragma unroll
        for (int ai = 0; ai < 2; ++ai)
#pragma unroll
            for (int m = 0; m < 4; ++m) sav[ai][m] = I8 ? sA[row0 + ai * HALF + m * 16] : 1.f;
        asm volatile("" : "+v"(sav[0][0]), "+v"(sav[0][1]), "+v"(sav[0][2]), "+v"(sav[0][3]), "+v"(sav[1][0]), "+v"(sav[1][1]), "+v"(sav[1][2]), "+v"(sav[1][3]));
#pragma unroll
        for (int ai = 0; ai < 2; ++ai)
#pragma unroll
            for (int m = 0; m < 4; ++m) { bf16_t* rowp = O + u.oo + (size_t)(row0 + ai * HALF + m * 16) * ldc + col0;
                const float sa = sav[ai][m];
                const f32x4 g0 = accval(acc[ai][0][m][0], sa, sb[0][0]), g1 = accval(acc[ai][0][m][1], sa, sb[0][1]), u0 = accval(acc[ai][1][m][0], sa, sb[1][0]), u1 = accval(acc[ai][1][m][1], sa, sb[1][1]);
                u32x4 w; w.x = cvt_pk_bf16(silu_mul(g0[0], u0[0]), silu_mul(g0[1], u0[1])); w.y = cvt_pk_bf16(silu_mul(g0[2], u0[2]), silu_mul(g0[3], u0[3]));
                w.z = cvt_pk_bf16(silu_mul(g1[0], u1[0]), silu_mul(g1[1], u1[1])); w.w = cvt_pk_bf16(silu_mul(g1[2], u1[2]), silu_mul(g1[3], u1[3]));
                *(u32x4*)rowp = w; }
    }
};
struct EpiResF32 {
    static constexpr bool PERM = false, AFTER_DRAIN = false;
    const float* base; float* out; int ldc;
    __device__ __forceinline__ void operator()(const f32x4 (&acc)[2][2][4][2], const Unit& u, int wr, int wc, int fr, int fq) const {
        const int row0 = u.pm * BM + wr * 64 + fr, col0 = u.pn * BM + wc * 32 + 4 * fq;
#pragma unroll
        for (int ai = 0; ai < 2; ++ai) {
            f32x4 bs[4][2][2];
#pragma unroll
            for (int m = 0; m < 4; ++m) { const size_t off = (size_t)(row0 + ai * HALF + m * 16) * ldc + col0;
#pragma unroll
                for (int bj = 0; bj < 2; ++bj)
#pragma unroll
                    for (int n = 0; n < 2; ++n) bs[m][bj][n] = *(const f32x4*)(base + off + bj * HALF + n * 16); }
#pragma unroll
            for (int m = 0; m < 4; ++m)
#pragma unroll
                for (int bj = 0; bj < 2; ++bj)
#pragma unroll
                    for (int n = 0; n < 2; ++n) asm volatile("" : "+v"(bs[m][bj][n]));
#pragma unroll
            for (int m = 0; m < 4; ++m) { const size_t off = (size_t)(row0 + ai * HALF + m * 16) * ldc + col0;
#pragma unroll
                for (int bj = 0; bj < 2; ++bj)
#pragma unroll
                    for (int n = 0; n < 2; ++n) *(f32x4*)(out + off + bj * HALF + n * 16) = bs[m][bj][n] + acc[ai][bj][m][n]; } }
    }
};

template <class Epi, class Sched, bool ALIGN_EPI = false, bool SP2 = false, bool I8 = false>
__device__ __forceinline__ void gemm_phase(PG8_LAS unsigned char* lds, const Gemm g, const Sched& S, const Epi& E) {
    const int tid = threadIdx.x, wid = __builtin_amdgcn_readfirstlane(tid >> 6), lane = tid & 63, wr = wid >> 2, wc = wid & 3, fr = lane & 15, fq = lane >> 4;
    constexpr int ES = I8 ? 1 : 2;
    typedef typename AccSel<I8>::type acc_t;
    const int K = g.K, nt = K * ES / (BK * 2);
    unsigned voffA[2], voffB[2];
#pragma unroll
    for (int i = 0; i < 2; ++i) { int R, C; stage_rc(tid * 16 + i * 8192, R, C); const int Rb = Epi::PERM ? ((R & ~31) + perm32(R & 31)) : R;
        voffA[i] = (unsigned)(R * g.ld * ES + C * 2); voffB[i] = (unsigned)(Rb * g.ld * ES + C * 2); }
    const size_t kstep = (size_t)(BK * 2);
    const size_t hstep = (size_t)HALF * g.ld * ES;
    const size_t tstep = 2 * hstep;
    const unsigned ldsw = (unsigned)wid * 1024u;
    const int aoff = lds_byte(wr * 64 + fr, fq * 8), boff = lds_byte(wc * 32 + fr, fq * 8);
#define PG8_SA(b, h) (((b) * 2 + (h)) * HTB)
#define PG8_SB(b, h) ((4 + (b) * 2 + (h)) * HTB)
#define PG8_STAGE(bufoff, gbase, voff) do { _Pragma("unroll") for (int _i = 0; _i < 2; ++_i) \
        __builtin_amdgcn_global_load_lds((const unsigned*)((const char*)(gbase) + (voff)[_i]), (PG8_LAS unsigned*)(lds + (bufoff) + ldsw + _i * 8192), 16, 0, 0); } while (0)
#define PG8_LDA(dst, b, h) do { _Pragma("unroll") for (int m = 0; m < 4; ++m) _Pragma("unroll") for (int k = 0; k < 2; ++k) dst[m][k] = *(const PG8_LAS bf16x8*)(lds + PG8_SA(b, h) + aoff + m * 2048 + k * 1024); } while (0)
#define PG8_LDB(dst, b, h) do { _Pragma("unroll") for (int n = 0; n < 2; ++n) _Pragma("unroll") for (int k = 0; k < 2; ++k) dst[n][k] = *(const PG8_LAS bf16x8*)(lds + PG8_SB(b, h) + boff + n * 2048 + k * 1024); } while (0)
#define PG8_MMA(ai, bj, At, Bt) do { __builtin_amdgcn_s_setprio(1); _Pragma("unroll") for (int m = 0; m < 4; ++m) _Pragma("unroll") for (int n = 0; n < 2; ++n) _Pragma("unroll") for (int k = 0; k < 2; ++k) \
        mma16(acc[ai][bj][m][n], Bt[n][k], At[m][k]); __builtin_amdgcn_s_setprio(0); } while (0)
#define PG8_WAIT_V(n) asm volatile("s_waitcnt vmcnt(" #n ")" ::: "memory")
#define PG8_WAIT_L(n) asm volatile("s_waitcnt lgkmcnt(" #n ")" ::: "memory")
#define PG8_BAR __builtin_amdgcn_s_barrier()
#define PG8_SCHED __builtin_amdgcn_sched_barrier(0)
    Unit cur, nxt; int ui = 0;
    if (!S.next(0, cur)) return;
    acc_t acc[2][2][4][2];
#pragma unroll
    for (int a = 0; a < 2; ++a)
#pragma unroll
        for (int b = 0; b < 2; ++b)
#pragma unroll
            for (int m = 0; m < 4; ++m)
#pragma unroll
                for (int n = 0; n < 2; ++n) acc[a][b][m][n] = acc_t{};
    bf16x8 At[4][2], B0[2][2], B1[2][2];
    const char* cA = (const char*)g.A + cur.ao + (size_t)cur.pm * tstep; const char* cB = (const char*)g.Bt + cur.bo + (size_t)cur.pn * tstep;
    S.a_ready(cur);
    if constexpr (SP2) {
        PG8_STAGE(PG8_SB(0, 0), cB, voffB); PG8_STAGE(PG8_SB(0, 1), cB + hstep, voffB); PG8_STAGE(PG8_SA(0, 0), cA, voffA); PG8_STAGE(PG8_SA(0, 1), cA + hstep, voffA);
        if (wr == 1) PG8_BAR;
        PG8_WAIT_V(2); PG8_BAR;
        PG8_STAGE(PG8_SB(1, 0), cB + kstep, voffB); PG8_STAGE(PG8_SA(1, 0), cA + kstep, voffA); PG8_STAGE(PG8_SB(1, 1), cB + hstep + kstep, voffB);
        PG8_WAIT_V(6); PG8_BAR;
    } else {
        PG8_STAGE(PG8_SB(0, 0), cB, voffB); PG8_STAGE(PG8_SA(0, 0), cA, voffA); PG8_STAGE(PG8_SB(0, 1), cB + hstep, voffB); PG8_STAGE(PG8_SA(0, 1), cA + hstep, voffA);
        if (wr == 1) PG8_BAR;
        PG8_WAIT_V(4); PG8_BAR;
        PG8_STAGE(PG8_SB(1, 0), cB + kstep, voffB); PG8_STAGE(PG8_SA(1, 0), cA + kstep, voffA); PG8_STAGE(PG8_SB(1, 1), cB + hstep + kstep, voffB);
        PG8_WAIT_V(6); PG8_BAR;
    }
    for (;;) {
        const bool has_next = S.next(ui + 1, nxt);
        const char* nA = has_next ? (const char*)g.A + nxt.ao + (size_t)nxt.pm * tstep : cA; const char* nB = has_next ? (const char*)g.Bt + nxt.bo + (size_t)nxt.pn * tstep : cB;
        for (int t = 0; t < nt; t += 2) {
            const bool last = (t == nt - 2);
            const char* a1 = cA + (size_t)(t + 1) * kstep;
            const char* a2 = last ? nA : cA + (size_t)(t + 2) * kstep; const char* b2 = last ? nB : cB + (size_t)(t + 2) * kstep;
            const char* a3 = a2 + kstep; const char* b3 = b2 + kstep;
            if (last && has_next) S.a_ready(nxt);
            if constexpr (SP2) {
            PG8_LDB(B0, 0, 0); PG8_LDB(B1, 0, 1); PG8_SCHED; PG8_LDA(At, 0, 0); PG8_STAGE(PG8_SA(1, 1), a1 + hstep, voffA);
            PG8_WAIT_V(8); PG8_WAIT_L(0); PG8_BAR; PG8_MMA(0, 0, At, B0); PG8_MMA(0, 1, At, B1); PG8_BAR; PG8_SCHED;
            PG8_LDA(At, 0, 1); PG8_STAGE(PG8_SB(0, 0), b2, voffB); PG8_STAGE(PG8_SB(0, 1), b2 + hstep, voffB); PG8_STAGE(PG8_SA(0, 0), a2, voffA);
            PG8_WAIT_V(8); PG8_WAIT_L(0); PG8_BAR; PG8_MMA(1, 0, At, B0); PG8_MMA(1, 1, At, B1); PG8_BAR; PG8_SCHED;
            PG8_LDB(B0, 1, 0); PG8_LDB(B1, 1, 1); PG8_SCHED; PG8_LDA(At, 1, 0); PG8_STAGE(PG8_SA(0, 1), a2 + hstep, voffA);
            PG8_WAIT_V(8); PG8_WAIT_L(0); PG8_BAR; PG8_MMA(0, 0, At, B0); PG8_MMA(0, 1, At, B1); PG8_BAR; PG8_SCHED;
            PG8_LDA(At, 1, 1); PG8_STAGE(PG8_SB(1, 0), b3, voffB); PG8_STAGE(PG8_SB(1, 1), b3 + hstep, voffB); PG8_STAGE(PG8_SA(1, 0), a3, voffA);
            PG8_WAIT_V(8); PG8_WAIT_L(0); PG8_BAR; PG8_MMA(1, 0, At, B0); PG8_MMA(1, 1, At, B1); PG8_BAR; PG8_SCHED;
            } else {
            PG8_LDB(B0, 0, 0); PG8_SCHED; PG8_LDA(At, 0, 0); PG8_STAGE(PG8_SA(1, 1), a1 + hstep, voffA);
            PG8_WAIT_L(8); PG8_BAR; PG8_WAIT_L(0); PG8_MMA(0, 0, At, B0); PG8_BAR; PG8_SCHED;
            PG8_LDB(B1, 0, 1); PG8_STAGE(PG8_SB(0, 0), b2, voffB);
            PG8_BAR; PG8_WAIT_L(0); PG8_MMA(0, 1, At, B1); PG8_BAR;
            PG8_LDA(At, 0, 1); PG8_STAGE(PG8_SA(0, 0), a2, voffA);
            PG8_BAR; PG8_WAIT_L(0); PG8_MMA(1, 0, At, B0); PG8_BAR; PG8_SCHED;
            PG8_STAGE(PG8_SB(0, 1), b2 + hstep, voffB);
            PG8_WAIT_V(6); PG8_BAR; PG8_MMA(1, 1, At, B1); PG8_BAR;
            PG8_LDB(B0, 1, 0); PG8_SCHED; PG8_LDA(At, 1, 0); PG8_STAGE(PG8_SA(0, 1), a2 + hstep, voffA);
            PG8_WAIT_L(8); PG8_BAR; PG8_WAIT_L(0); PG8_MMA(0, 0, At, B0); PG8_BAR; PG8_SCHED;
            PG8_LDB(B1, 1, 1); PG8_STAGE(PG8_SB(1, 0), b3, voffB);
            PG8_BAR; PG8_WAIT_L(0); PG8_MMA(0, 1, At, B1); PG8_BAR;
            PG8_LDA(At, 1, 1); PG8_STAGE(PG8_SA(1, 0), a3, voffA);
            PG8_BAR; PG8_WAIT_L(0); PG8_MMA(1, 0, At, B0); PG8_BAR; PG8_SCHED;
            PG8_STAGE(PG8_SB(1, 1), b3 + hstep, voffB);
            PG8_WAIT_V(6); PG8_BAR; PG8_MMA(1, 1, At, B1); PG8_BAR;
            }
        }
        if constexpr (ALIGN_EPI) { if (wr == 0) PG8_BAR; }
        if constexpr (!Epi::AFTER_DRAIN) { E(acc, cur, wr, wc, fr, fq); S.done(cur); }
        if (!has_next) break;
#pragma unroll
        for (int a = 0; a < 2; ++a)
#pragma unroll
            for (int b = 0; b < 2; ++b)
#pragma unroll
                for (int m = 0; m < 4; ++m)
#pragma unroll
                    for (int n = 0; n < 2; ++n) acc[a][b][m][n] = acc_t{};
        cur = nxt; cA = nA; cB = nB; ++ui;
        if constexpr (ALIGN_EPI) { if (wr == 1) PG8_BAR; }
    }
    PG8_WAIT_V(0);
    if constexpr (!ALIGN_EPI) { if (wr == 0) PG8_BAR; }
    PG8_BAR;
    if constexpr (Epi::AFTER_DRAIN) { E.fused(acc, cur, wr, wc, fr, fq, lds, wid, lane); S.done(cur); }
#undef PG8_SA
#undef PG8_SB
#undef PG8_STAGE
#undef PG8_LDA
#undef PG8_LDB
#undef PG8_MMA
#undef PG8_WAIT_V
#undef PG8_WAIT_L
#undef PG8_BAR
#undef PG8_SCHED
}
}

namespace att {
typedef unsigned short bf16;
typedef short bf16x8 __attribute__((ext_vector_type(8)));
typedef short s16x4 __attribute__((ext_vector_type(4)));
typedef float f32x16 __attribute__((ext_vector_type(16)));
typedef float f32x4 __attribute__((ext_vector_type(4)));
typedef unsigned u32x4 __attribute__((ext_vector_type(4)));
typedef float f32x2_t __attribute__((ext_vector_type(2))); typedef __bf16 bf16x2_t __attribute__((ext_vector_type(2)));
constexpr int SEQ = 4096;
constexpr float LOG2E = 1.4426950408889634f;
struct Args { const bf16* Q; int qpitch, qhs; const bf16* K; int kpitch, khs; const bf16* K2; const bf16* V; int vpitch, vhs; bf16* O; const float* cosT; const float* sinT; const float* relb; const float* sinks; };

__device__ __forceinline__ int crow(int r, int hi) { return (r & 3) + 8 * (r >> 2) + 4 * hi; }
__device__ __forceinline__ unsigned cvtpk(float lo, float hi) { f32x2_t v = {lo, hi}; bf16x2_t b = __builtin_convertvector(v, bf16x2_t); return __builtin_bit_cast(unsigned, b); }
__device__ __forceinline__ float bf2f(unsigned short h) { return __builtin_bit_cast(float, (unsigned)h << 16); }
__device__ __forceinline__ unsigned short f2bf(float f) { unsigned u = __builtin_bit_cast(unsigned, f); return (unsigned short)((u + 0x7fffu + ((u >> 16) & 1u)) >> 16); }
__device__ __forceinline__ float ex2(float x) { return __builtin_amdgcn_exp2f(x); }
__device__ __forceinline__ float lg2(float x) { return __builtin_amdgcn_logf(x); }
#define ATT_SBAR() __builtin_amdgcn_sched_barrier(0)
__device__ __forceinline__ void pv(f32x16* o, int vb, bf16x8 pa0, bf16x8 pa1, bf16x8 pa2, bf16x8 pa3) {
  s16x4 lo0[4], hi0[4], lo1[4], hi1[4];
#pragma unroll
  for (int ks = 0; ks < 4; ++ks) {
    asm volatile("ds_read_b64_tr_b16 %0,%1 offset:%c2" : "=&v"(lo0[ks]) : "v"(vb), "i"(ks * 1024) : "memory");
    asm volatile("ds_read_b64_tr_b16 %0,%1 offset:%c2" : "=&v"(hi0[ks]) : "v"(vb), "i"(ks * 1024 + 512) : "memory"); }
#pragma unroll
  for (int ks = 0; ks < 4; ++ks) {
    asm volatile("ds_read_b64_tr_b16 %0,%1 offset:%c2" : "=&v"(lo1[ks]) : "v"(vb), "i"(4096 + ks * 1024) : "memory");
    asm volatile("ds_read_b64_tr_b16 %0,%1 offset:%c2" : "=&v"(hi1[ks]) : "v"(vb), "i"(4096 + ks * 1024 + 512) : "memory"); }
  asm volatile("s_waitcnt lgkmcnt(8)" : "+v"(lo0[0]), "+v"(hi0[0]), "+v"(lo0[1]), "+v"(hi0[1]), "+v"(lo0[2]), "+v"(hi0[2]), "+v"(lo0[3]), "+v"(hi0[3]) :: "memory"); ATT_SBAR();
#define ATT_PK(lo, hi, k) (bf16x8){lo[k][0], lo[k][1], lo[k][2], lo[k][3], hi[k][0], hi[k][1], hi[k][2], hi[k][3]}
  o[0] = __builtin_amdgcn_mfma_f32_32x32x16_bf16(pa0, ATT_PK(lo0, hi0, 0), o[0], 0, 0, 0);
  o[0] = __builtin_amdgcn_mfma_f32_32x32x16_bf16(pa1, ATT_PK(lo0, hi0, 1), o[0], 0, 0, 0);
  o[0] = __builtin_amdgcn_mfma_f32_32x32x16_bf16(pa2, ATT_PK(lo0, hi0, 2), o[0], 0, 0, 0);
  o[0] = __builtin_amdgcn_mfma_f32_32x32x16_bf16(pa3, ATT_PK(lo0, hi0, 3), o[0], 0, 0, 0);
  asm volatile("s_waitcnt lgkmcnt(0)" : "+v"(lo1[0]), "+v"(hi1[0]), "+v"(lo1[1]), "+v"(hi1[1]), "+v"(lo1[2]), "+v"(hi1[2]), "+v"(lo1[3]), "+v"(hi1[3]) :: "memory"); ATT_SBAR();
  o[1] = __builtin_amdgcn_mfma_f32_32x32x16_bf16(pa0, ATT_PK(lo1, hi1, 0), o[1], 0, 0, 0);
  o[1] = __builtin_amdgcn_mfma_f32_32x32x16_bf16(pa1, ATT_PK(lo1, hi1, 1), o[1], 0, 0, 0);
  o[1] = __builtin_amdgcn_mfma_f32_32x32x16_bf16(pa2, ATT_PK(lo1, hi1, 2), o[1], 0, 0, 0);
  o[1] = __builtin_amdgcn_mfma_f32_32x32x16_bf16(pa3, ATT_PK(lo1, hi1, 3), o[1], 0, 0, 0);
#undef ATT_PK
}
__device__ __forceinline__ float max3f(float a, float b, float c) { float r; asm("v_max3_f32 %0, %1, %2, %3" : "=v"(r) : "v"(a), "v"(b), "v"(c)); return r; }
__device__ __forceinline__ float xmax(float v) { auto rr = __builtin_amdgcn_permlane32_swap(__float_as_uint(v), __float_as_uint(v), false, false); return fmaxf(__uint_as_float(rr[0]), __uint_as_float(rr[1])); }
__device__ __forceinline__ float xsum(float v) { auto rr = __builtin_amdgcn_permlane32_swap(__float_as_uint(v), __float_as_uint(v), false, false); return __uint_as_float(rr[0]) + __uint_as_float(rr[1]); }

__device__ __forceinline__ void softmax_tile(f32x16& p0, f32x16& p1, float& m, float& l, f32x16& negm, f32x16& o0, f32x16& o1, f32x16& q0, f32x16& q1, LAS float* wsf, int r32, int hi) {
  constexpr float THR = 8.f;
  float a = max3f(p0[0], p0[1], p1[0]), b = max3f(p0[2], p0[3], p1[1]); a = max3f(a, p1[2], p1[3]);
#pragma unroll
  for (int r = 4; r < 16; r += 4) { a = max3f(a, p0[r], p0[r + 1]); b = max3f(b, p0[r + 2], p0[r + 3]); a = max3f(a, p1[r], p1[r + 1]); b = max3f(b, p1[r + 2], p1[r + 3]); }
  const float rm = xmax(max3f(a, b, b));
  if (__any(rm > THR || (l == 0.f && rm < -40.f && rm > -1e29f))) {
    const float dl = (rm > 0.f || (l == 0.f && rm < -40.f && rm > -1e29f)) ? rm : 0.f;
    m += dl;
#pragma unroll
    for (int r = 0; r < 16; ++r) { negm[r] = -m; p0[r] -= dl; p1[r] -= dl; q0[r] -= dl; q1[r] -= dl; }
    const float f = ex2(-dl); l *= f;
    if (hi == 0) wsf[r32] = f;
#pragma unroll
    for (int r = 0; r < 16; ++r) { const float fr = wsf[crow(r, hi)]; o0[r] *= fr; o1[r] *= fr; }
  }
  float rs = 0.f;
#pragma unroll
  for (int r = 0; r < 16; ++r) { p0[r] = ex2(p0[r]); p1[r] = ex2(p1[r]); rs += p0[r] + p1[r]; }
  l += xsum(rs);
}

template <int MODE> struct Lay {
  static constexpr int DKC = (MODE == 2) ? 12 : 8, ND0 = DKC / 2, KSLOT = DKC * 1024, VSLOT = 8192;
  static constexpr int NSL = 4;
  static constexpr int OFF_K = 0, OFF_V = NSL * KSLOT, OFF_WS = OFF_V + NSL * VSLOT, OFF_BT = OFF_WS + 8 * 256, OFF_FL = OFF_BT + 8 * 512, OFF_OST = OFF_FL + 256, TOTAL = OFF_OST + 8 * 4096;
};

template <int MODE>
__device__ __forceinline__ void attn_unit(LAS char* shm, const Args& A, int b, int hsel, int qblk) {
  typedef Lay<MODE> L;
  constexpr int ND0 = L::ND0, KSLOT = L::KSLOT, VSLOT = L::VSLOT;
  constexpr float NEG = -1e30f;
  const int tid = threadIdx.x, lane = tid & 63, r32 = lane & 31, hi = lane >> 5;
  const int wid = __builtin_amdgcn_readfirstlane(tid >> 6);
  const long rowbase = (long)b * SEQ;
  const int qrow0 = (MODE == 0) ? 32 * qblk : 256 * qblk + 32 * wid;
  const int head = (MODE == 0) ? hsel * 8 + wid : hsel;
  int tlo, thi;
  if (MODE == 0) { tlo = qrow0 >= 127 ? (qrow0 - 127) >> 6 : 0; thi = (qrow0 + 31) >> 6; } else { tlo = 0; thi = 4 * qblk + 3; }
  const int wmax = (MODE == 1) ? (qrow0 + 30) >> 6 : (qrow0 + 31) >> 6;
  const int n = thi - tlo + 1;
  LAS float* wsf = (LAS float*)(shm + L::OFF_WS) + wid * 64;
  LAS float* btab = (LAS float*)(shm + L::OFF_BT) + wid * 128;
  LAS unsigned* fl = (LAS unsigned*)(shm + L::OFF_FL);
  const int q = qrow0 + r32;
  const bf16* Qw = A.Q + (rowbase + q) * (long)A.qpitch + head * A.qhs + hi * 8;
  bf16x8 qr[ND0];
#pragma unroll
  for (int d0 = 0; d0 < ND0; ++d0) qr[d0] = *(const bf16x8*)(Qw + d0 * 16);
  if (MODE == 2) {
    const f32x4* cp = (const f32x4*)(A.cosT + q * 16 + hi * 8); const f32x4* sp = (const f32x4*)(A.sinT + q * 16 + hi * 8);
    const f32x4 c0 = cp[0], c1 = cp[1], s0 = sp[0], s1 = sp[1];
#pragma unroll
    for (int j = 0; j < 8; ++j) { const float c = j < 4 ? c0[j & 3] : c1[j & 3], s = j < 4 ? s0[j & 3] : s1[j & 3];
      const float x1 = bf2f((unsigned short)qr[ND0 - 2][j]), x2 = bf2f((unsigned short)qr[ND0 - 1][j]);
      qr[ND0 - 2][j] = (short)f2bf(x1 * c - x2 * s); qr[ND0 - 1][j] = (short)f2bf(x1 * s + x2 * c); }
  }
  float m = 0.f, l = 0.f, cp = 1.f; bool wdone = false;
  if (MODE == 0) {
    for (int d = lane; d < 128; d += 64) { int bk = d; if (d >= 16) { bk = 16 + (int)(__logf((float)d * (1.f / 16.f)) * (16.f / 2.0794415416798357f)); bk = bk > 31 ? 31 : bk; }
      btab[d] = A.relb[bk * 16 + head] * LOG2E; }
    m = A.sinks[head] * LOG2E; l = 1.f;
  }
  f32x16 negm;
#pragma unroll
  for (int r = 0; r < 16; ++r) negm[r] = (MODE == 1) ? 0.f : -m;
  f32x16 o[2]; o[0] = f32x16{}; o[1] = f32x16{};
  const bf16* ksrc = A.K + (rowbase + lane) * (long)A.kpitch + hsel * A.khs + wid * 8;
  const bf16* k2src = (MODE == 2) ? A.K2 + (rowbase + lane) * 32 + (wid & 3) * 8 : nullptr;
  const bf16* vsrc = A.V + (rowbase + 16 * (wid & 3) + (lane >> 2)) * (long)A.vpitch + hsel * A.vhs + (wid >> 2) * 32 + (lane & 3) * 8;
  const int vb0 = (int)(unsigned)(uintptr_t)(shm + L::OFF_V) + ((lane >> 4) & 1) * 32 + (lane & 3) * 8 + (4 * hi + ((lane & 15) >> 2)) * 64;
  u32x4 kreg, k2reg = (u32x4){0u, 0u, 0u, 0u}, vreg;
  u32x4 kB = (u32x4){0u, 0u, 0u, 0u}, vB = kB, kC = kB, vC = kB;
#define ATT_TILE(i_) ((MODE == 1) ? thi - (i_) : tlo + (i_))
#define ATT_LOAD(t_) do { kreg = *(const u32x4*)(ksrc + (long)(t_) * 64 * A.kpitch); vreg = *(const u32x4*)(vsrc + (long)(t_) * 64 * A.vpitch); \
    if (MODE == 2 && wid < 4) k2reg = *(const u32x4*)(k2src + (long)(t_) * 64 * 32); } while (0)
#define ATT_STAGE(sl_) do { *(LAS u32x4*)(shm + L::OFF_K + (sl_) * KSLOT + wid * 1024 + lane * 16) = kreg; \
    if (MODE == 2 && wid < 4) *(LAS u32x4*)(shm + L::OFF_K + (sl_) * KSLOT + (8 + wid) * 1024 + lane * 16) = k2reg; \
    *(LAS u32x4*)(shm + L::OFF_V + (sl_) * VSLOT + wid * 1024 + lane * 16) = vreg; } while (0)
#define ATT_QK(P0, P1, sl_) do { LAS const char* kb_ = shm + L::OFF_K + (sl_) * KSLOT + hi * 1024 + r32 * 16; bf16x8 kf_[2 * ND0]; \
    _Pragma("unroll") for (int d0 = 0; d0 < ND0; ++d0) { kf_[2 * d0] = *(LAS const bf16x8*)(kb_ + d0 * 2048); kf_[2 * d0 + 1] = *(LAS const bf16x8*)(kb_ + d0 * 2048 + 512); } \
    P0 = __builtin_amdgcn_mfma_f32_32x32x16_bf16(kf_[0], qr[0], negm, 0, 0, 0); P1 = __builtin_amdgcn_mfma_f32_32x32x16_bf16(kf_[1], qr[0], negm, 0, 0, 0); \
    _Pragma("unroll") for (int d0 = 1; d0 < ND0; ++d0) { P0 = __builtin_amdgcn_mfma_f32_32x32x16_bf16(kf_[2 * d0], qr[d0], P0, 0, 0, 0); P1 = __builtin_amdgcn_mfma_f32_32x32x16_bf16(kf_[2 * d0 + 1], qr[d0], P1, 0, 0, 0); } } while (0)
  ATT_LOAD(ATT_TILE(0));
  if (MODE == 0) { if (n > 1) { kB = *(const u32x4*)(ksrc + (long)ATT_TILE(1) * 64 * A.kpitch); vB = *(const u32x4*)(vsrc + (long)ATT_TILE(1) * 64 * A.vpitch); }
                   if (n > 2) { kC = *(const u32x4*)(ksrc + (long)ATT_TILE(2) * 64 * A.kpitch); vC = *(const u32x4*)(vsrc + (long)ATT_TILE(2) * 64 * A.vpitch); } }
  ATT_STAGE(0);
  if (MODE != 0 && n > 1) ATT_LOAD(ATT_TILE(1));
  __syncthreads();
  f32x16 p0 = f32x16{}, p1 = f32x16{}, q0 = f32x16{}, q1 = f32x16{};
  if (ATT_TILE(0) <= wmax) ATT_QK(p0, p1, 0);
  int sl = 0, sln = 1;
  bool have_pv = false; int pv_sl = 0; u32x4 pw0 = (u32x4){0u, 0u, 0u, 0u}, pw1 = pw0, pw2 = pw0, pw3 = pw0;
  for (int i = 0; i < n; ++i) {
    const int t = ATT_TILE(i);
    if (MODE == 0) { if (i == 0) { kreg = kB; vreg = vB; } else { kreg = kC; vreg = vC; } }
    if (i + 1 < n) ATT_STAGE(sln);
    __syncthreads();
    if (MODE == 1 && i >= 1) { const int fb = (i & 1) * 8; unsigned a = fl[fb + 0] & fl[fb + 1] & fl[fb + 2] & fl[fb + 3] & fl[fb + 4] & fl[fb + 5] & fl[fb + 6] & fl[fb + 7];
      if (__builtin_amdgcn_readfirstlane(a)) break; }
    if (MODE != 0 && i + 2 < n) ATT_LOAD(ATT_TILE(i + 2));
    if (i + 1 < n && ATT_TILE(i + 1) <= wmax && !(MODE == 1 && wdone)) ATT_QK(q0, q1, sln);
    if (have_pv) { pv(o, vb0 + pv_sl * VSLOT, __builtin_bit_cast(bf16x8, pw0), __builtin_bit_cast(bf16x8, pw1), __builtin_bit_cast(bf16x8, pw2), __builtin_bit_cast(bf16x8, pw3)); have_pv = false; }
    ATT_SBAR();
    if (t <= wmax && !(MODE == 1 && wdone)) {
      const int kt0 = t * 64;
      if (MODE == 2) {
        if (kt0 + 63 > qrow0) {
#pragma unroll
          for (int r = 0; r < 16; ++r) { const int key = kt0 + crow(r, hi); if (key > q) p0[r] = NEG; if (key + 32 > q) p1[r] = NEG; }
        }
        softmax_tile(p0, p1, m, l, negm, o[0], o[1], q0, q1, wsf, r32, hi);
      } else if (MODE == 0) {
#pragma unroll
        for (int r = 0; r < 16; ++r) { const int d0_ = q - (kt0 + crow(r, hi)), d1_ = d0_ - 32;
          const float b0_ = btab[d0_ & 127], b1_ = btab[d1_ & 127];
          p0[r] = ((unsigned)d0_ < 128u) ? p0[r] + b0_ : NEG; p1[r] = ((unsigned)d1_ < 128u) ? p1[r] + b1_ : NEG; }
        softmax_tile(p0, p1, m, l, negm, o[0], o[1], q0, q1, wsf, r32, hi);
      } else {
        const bool need_mask = (kt0 + 63 >= qrow0);
        f32x16 l0, l1;
#pragma unroll
        for (int r = 0; r < 16; ++r) {
          { const float e = ex2(-fmaxf(p0[r], -100.f)); float sg = __builtin_amdgcn_rcpf(1.f + e); float fl_ = e * sg; if (need_mask && (kt0 + crow(r, hi) >= q)) { sg = 0.f; fl_ = 1.f; } p0[r] = sg; l0[r] = fl_; }
          { const float e = ex2(-fmaxf(p1[r], -100.f)); float sg = __builtin_amdgcn_rcpf(1.f + e); float fl_ = e * sg; if (need_mask && (kt0 + 32 + crow(r, hi) >= q)) { sg = 0.f; fl_ = 1.f; } p1[r] = sg; l1[r] = fl_; }
        }
        float gs[8], pg[8];
#pragma unroll
        for (int c = 0; c < 4; ++c) { gs[c] = (l0[4 * c] * l0[4 * c + 1]) * (l0[4 * c + 2] * l0[4 * c + 3]); gs[4 + c] = (l1[4 * c] * l1[4 * c + 1]) * (l1[4 * c + 2] * l1[4 * c + 3]); }
#pragma unroll
        for (int ch = 0; ch < 8; ++ch) pg[ch] = __shfl_xor(gs[ch], 32);
        float suf = cp;
#pragma unroll
        for (int ch = 7; ch >= 4; --ch) { float run = (hi == 0) ? suf * pg[ch] : suf;
#pragma unroll
          for (int k = 3; k >= 0; --k) { const int r = 4 * (ch - 4) + k; p1[r] *= run; run *= l1[r]; }
          suf *= gs[ch] * pg[ch]; }
#pragma unroll
        for (int ch = 3; ch >= 0; --ch) { float run = (hi == 0) ? suf * pg[ch] : suf;
#pragma unroll
          for (int k = 3; k >= 0; --k) { const int r = 4 * ch + k; p0[r] *= run; run *= l0[r]; }
          suf *= gs[ch] * pg[ch]; }
        cp = suf;
        wdone = __all(cp == 0.f);
      }
      pw0 = (u32x4){cvtpk(p0[0], p0[1]), cvtpk(p0[2], p0[3]), cvtpk(p0[4], p0[5]), cvtpk(p0[6], p0[7])};
      pw1 = (u32x4){cvtpk(p0[8], p0[9]), cvtpk(p0[10], p0[11]), cvtpk(p0[12], p0[13]), cvtpk(p0[14], p0[15])};
      pw2 = (u32x4){cvtpk(p1[0], p1[1]), cvtpk(p1[2], p1[3]), cvtpk(p1[4], p1[5]), cvtpk(p1[6], p1[7])};
      pw3 = (u32x4){cvtpk(p1[8], p1[9]), cvtpk(p1[10], p1[11]), cvtpk(p1[12], p1[13]), cvtpk(p1[14], p1[15])};
      have_pv = true; pv_sl = sl;
    }
    if (MODE == 1 && lane == 0) fl[((i + 1) & 1) * 8 + wid] = wdone ? 1u : 0u;
    p0 = q0; p1 = q1;
    sl = sln; sln = (sln == L::NSL - 1) ? 0 : sln + 1;
  }
  if (have_pv) pv(o, vb0 + pv_sl * VSLOT, __builtin_bit_cast(bf16x8, pw0), __builtin_bit_cast(bf16x8, pw1), __builtin_bit_cast(bf16x8, pw2), __builtin_bit_cast(bf16x8, pw3));
#undef ATT_TILE
#undef ATT_LOAD
#undef ATT_STAGE
#undef ATT_QK
  float rli[16];
  if (MODE != 1) {
    if (hi == 0) wsf[32 + r32] = l;
#pragma unroll
    for (int r = 0; r < 16; ++r) rli[r] = __builtin_amdgcn_rcpf(wsf[32 + crow(r, hi)]);
  } else {
#pragma unroll
    for (int r = 0; r < 16; ++r) rli[r] = 1.f;
  }
  { LAS bf16* stg = (LAS bf16*)(shm + L::OFF_OST) + wid * 2048;
#pragma unroll
    for (int r = 0; r < 16; ++r) { const int orow = crow(r, hi);
#pragma unroll
      for (int d0 = 0; d0 < 2; ++d0) stg[orow * 64 + d0 * 32 + r32] = f2bf(o[d0][r] * rli[r]); }
    bf16* Ow = A.O + (rowbase + qrow0) * 1024 + head * 64;
#pragma unroll
    for (int i = 0; i < 4; ++i) { const int row = i * 8 + (lane >> 3), ch = lane & 7; const u32x4 v = *(LAS const u32x4*)(stg + row * 64 + ch * 8); *(u32x4*)(Ow + (long)row * 1024 + ch * 8) = v; } }
  asm volatile("s_waitcnt lgkmcnt(0)\n\ts_barrier" ::: "memory");
}

template <int MODE>
__device__ __forceinline__ void attn_phase(LAS char* shm, const Args& A, int G, int c) {
  for (int s = c; s < 2048; s += G) {
    const int cc = s & 255, i = s >> 8;
    int b, hsel, qblk;
    if (MODE == 0) { const int u = cc * 8 + i; b = u >> 8; hsel = (u >> 7) & 1; qblk = u & 127; }
    else { const int bh = cc >> 1, par = cc & 1; b = bh >> 4; hsel = bh & 15;
      if (MODE == 2) qblk = (i & 1) ? 15 - (i - 1) - par : i + par;
      else qblk = 2 * i + par; }
    attn_unit<MODE>(shm, A, b, hsel, qblk);
  }
}

template <int MODE>
__device__ __forceinline__ void attn_naive(const Args& A, int G, int c) {
  constexpr int DK = (MODE == 2) ? 96 : 64;
  for (int ch = c; ch < 1024; ch += G) {
    const int b = ch >> 7, head = (ch >> 3) & 15, q = (ch & 7) * 512 + (int)threadIdx.x;
    const int kvh = (MODE == 0) ? head >> 3 : head;
    const long rowbase = (long)b * SEQ;
    float qv[DK];
    { const bf16* qp = A.Q + (rowbase + q) * (long)A.qpitch + head * A.qhs;
#pragma unroll
      for (int d = 0; d < DK; ++d) qv[d] = bf2f(qp[d]); }
    if (MODE == 2) {
#pragma unroll
      for (int i = 0; i < 16; ++i) { const float cs = A.cosT[q * 16 + i], sn = A.sinT[q * 16 + i]; const float x1 = qv[DK - 32 + i], x2 = qv[DK - 16 + i];
        qv[DK - 32 + i] = bf2f(f2bf(x1 * cs - x2 * sn)); qv[DK - 16 + i] = bf2f(f2bf(x1 * sn + x2 * cs)); }
    }
    float o[64];
#pragma unroll
    for (int d = 0; d < 64; ++d) o[d] = 0.f;
    float m = -1e30f, l = 0.f, carry = 0.f;
    if (MODE == 0) { m = A.sinks[head] * LOG2E; l = 1.f; }
    const int nk = (MODE == 0) ? 128 : (MODE == 1 ? q : q + 1);
    for (int j = 0; j < nk; ++j) {
      const int key = (MODE == 0) ? q - j : (MODE == 1 ? q - 1 - j : j);
      if (key < 0) break;
      const bf16* kp = A.K + (rowbase + key) * (long)A.kpitch + kvh * A.khs;
      float s = 0.f;
#pragma unroll
      for (int d = 0; d < 64; ++d) s += qv[d] * bf2f(kp[d]);
      if (MODE == 2) { const bf16* k2 = A.K2 + (rowbase + key) * 32;
#pragma unroll
        for (int d = 0; d < 32; ++d) s += qv[64 + d] * bf2f(k2[d]); }
      const bf16* vp = A.V + (rowbase + key) * (long)A.vpitch + kvh * A.vhs;
      if (MODE == 1) {
        const float lf = -(fmaxf(s, 0.f) + lg2(1.f + ex2(-fabsf(s))));
        const float a = ex2(s + lf + carry); carry += lf;
#pragma unroll
        for (int d = 0; d < 64; ++d) o[d] += a * bf2f(vp[d]);
        if (carry < -152.f) break;
      } else {
        if (MODE == 0) { const int dist = j; int bk = dist; if (dist >= 16) { bk = 16 + (int)(__logf((float)dist * (1.f / 16.f)) * (16.f / 2.0794415416798357f)); bk = bk > 31 ? 31 : bk; } s += A.relb[bk * 16 + head] * LOG2E; }
        const float mn = fmaxf(m, s), f = ex2(m - mn), p = ex2(s - mn); l = l * f + p; m = mn;
#pragma unroll
        for (int d = 0; d < 64; ++d) o[d] = o[d] * f + p * bf2f(vp[d]);
      }
    }
    const float rl = (MODE == 1) ? 1.f : 1.f / l;
    bf16* op = A.O + (rowbase + q) * 1024 + head * 64;
#pragma unroll
    for (int d = 0; d < 64; ++d) op[d] = f2bf(o[d] * rl);
  }
}
#undef ATT_SBAR
}

constexpr int NWAVES = 8;
constexpr int BATCH = 8, SEQ = 4096, D = 1024, T = BATCH * SEQ;
constexpr int FFN = 2816, NEXP = 8, EDIM = 3584, PMAX = 67584;
constexpr int SWA_N = 1280, SB_N = 3072, MLA_DN = 768, MLA_QR = 384, MLA_KVR = 256, MLA_UQN = 1536, MLA_UKVN = 2048;
constexpr float RMS_EPS = 1e-6f, LOG2E = 1.4426950408889634f;
constexpr int NPH = 34;
typedef unsigned short bf16;
typedef unsigned v4u __attribute__((ext_vector_type(4)));
typedef unsigned v2u __attribute__((ext_vector_type(2)));
typedef float f32x4 __attribute__((ext_vector_type(4)));
typedef float f32x2 __attribute__((ext_vector_type(2)));
typedef int i32x2 __attribute__((ext_vector_type(2)));
typedef GAS unsigned gu32;
#define RLX_AGENT __ATOMIC_RELAXED, __HIP_MEMORY_SCOPE_AGENT
#define LDS_WAIT() asm volatile("s_waitcnt lgkmcnt(0)" ::: "memory")

constexpr size_t MiB = 1u << 20;
constexpr size_t WS_CTL = 0, CTL_ZERO_BYTES = 1 * MiB;
constexpr size_t WS_TAB = 1 * MiB;
constexpr size_t TAB_COS = 0, TAB_SIN = 256 * 1024, TAB_TOKE = 512 * 1024, TAB_TOKG = 640 * 1024, TAB_SLOT = 896 * 1024, TAB_SA = 1152 * 1024, TAB_SAP = 1280 * 1024, TAB_SB = 1600 * 1024, TAB_WCNT = 2200 * 1024;
constexpr size_t WS_WSM = 4 * MiB;
constexpr size_t WS_WMOE = 44 * MiB;
constexpr size_t WS_H = 156 * MiB;
constexpr size_t WS_SCR = 220 * MiB;
constexpr size_t WS_YP = 814 * MiB;
constexpr size_t YP_ELEMS = (size_t)2048 * 1024;
constexpr size_t WS_END = 842 * MiB;
constexpr size_t B_SWAO = 0, B_SBO = 4194304, B_MLAUQ = 6291456, B_MLAUKV = 7471104, B_MLAO = 8519680, B_FFND = 10616832,
                 B_SWAQKV = 22151168, B_SBQKV = 24772608, B_MLAD = 27918336, B_FFNGU = 28704768, B_SM_END = 40239104;
static_assert(B_SM_END <= 40 * MiB, "small weights fit");
constexpr size_t B_MOEGU_E = (size_t)2 * EDIM * D, B_MOED = 8 * B_MOEGU_E, B_MOED_E = (size_t)D * EDIM * 2;
static_assert(B_MOED + 8 * B_MOED_E <= 112 * MiB, "moe weights fit");
constexpr int SBO_SWAQKV = 0, SBO_SBQKV = 2560, SBO_MLAD = 5632, SBO_FFNGU = 6400, SBO_MOE = 17664, SBO_END = 17664 + 2 * 57344;
constexpr size_t SC_QKV = 0;
constexpr size_t SC_C = 0, SC_CQN = 48 * MiB, SC_CKVN = 72 * MiB, SC_KROPE = 88 * MiB, SC_QM = 90 * MiB, SC_KVM = 186 * MiB;
constexpr size_t SC_DELTA = 320 * MiB;
constexpr size_t SC_ACT = 0;
constexpr size_t SC_HPERM = 0, SC_MACT = 132 * MiB;
static_assert(SC_MACT + (size_t)PMAX * EDIM * 2 <= 594 * MiB && SC_KVM + (size_t)T * MLA_UKVN * 2 <= 594 * MiB, "scratch fits");
constexpr int CW_BAR = 4096, CW_CNT = 16384, CW_CUR = 16384 + 256, CW_AMAX = 32768;
static_assert((CW_AMAX + SBO_END) * 4 <= (int)CTL_ZERO_BYTES && TAB_SB + (size_t)SBO_END * 4 <= TAB_WCNT && TAB_WCNT + 2 * 4096 * 8 <= 3 * MiB, "ctl / tab maps");

__device__ __forceinline__ unsigned f2bf(float f) { unsigned u = __builtin_bit_cast(unsigned, f); return (u + 0x7fffu + ((u >> 16) & 1u)) >> 16; }
__device__ __forceinline__ unsigned pk2(float lo, float hi) { return f2bf(lo) | (f2bf(hi) << 16); }
__device__ __forceinline__ float bflo(unsigned w) { return __builtin_bit_cast(float, w << 16); }
__device__ __forceinline__ float bfhi(unsigned w) { return __builtin_bit_cast(float, w & 0xffff0000u); }
#define XB_TMO      128
#define XB_XCNT(j)  (256  + 64 * (j))
#define XB_XSUB(j)  (1280 + 64 * (j))
#define XB_XGEN(j)  (2304 + 64 * (j))
#define XB_TOP      3328
#define XB_TOPGEN   3392
#define XCD_BAR_WORDS 3456
#define XB_SPIN_CAP (1u << 18)

__device__ __forceinline__ unsigned xb_ld(unsigned* p)              { return __hip_atomic_load(p, __ATOMIC_RELAXED, __HIP_MEMORY_SCOPE_AGENT); }
__device__ __forceinline__ unsigned xb_add(unsigned* p, unsigned v) { return __hip_atomic_fetch_add(p, v, __ATOMIC_RELAXED, __HIP_MEMORY_SCOPE_AGENT); }
__device__ __forceinline__ unsigned xb_xcc_id() { return (unsigned)__builtin_amdgcn_s_getreg((3 << 11) | 20) & 0xFu; }
#define XB_SPIN(cond, bar) do { unsigned _sp = 0; while (cond) { __builtin_amdgcn_s_sleep(1); \
    if ((++_sp & 255u) == 0u) { if (xb_ld(&(bar)[XB_TMO])) break; if (_sp > XB_SPIN_CAP) { atomicAdd(&(bar)[XB_TMO], 1u); break; } } } } while (0)

struct XcdBarrier {
    unsigned* bar; unsigned x;
    volatile LAS unsigned* st;
};

__device__ __forceinline__ XcdBarrier xcd_barrier_post(unsigned* bar, volatile LAS unsigned* st) {
    XcdBarrier b; b.bar = bar; b.x = xb_xcc_id(); b.st = st;
    if (threadIdx.x == 0) (void)xb_add(&bar[XB_XCNT(b.x)], 1u);
    return b;
}
__device__ __forceinline__ void xcd_barrier_complete(unsigned* bar, unsigned x, unsigned& nloc, unsigned& nx) {
    const unsigned G = gridDim.x * gridDim.y * gridDim.z;
    unsigned sum, cnt, mine, sp = 0u;
    for (;;) {
        sum = 0u; cnt = 0u; mine = 0u;
#pragma unroll
        for (unsigned j = 0; j < 16; ++j) { const unsigned c = xb_ld(&bar[XB_XCNT(j)]); sum += c; cnt += (c > 0u) ? 1u : 0u; mine = (j == x) ? c : mine; }
        if (sum == G) break;
        __builtin_amdgcn_s_sleep(1);
        if ((++sp & 255u) == 0u) { if (xb_ld(&bar[XB_TMO])) break; if (sp > XB_SPIN_CAP) { atomicAdd(&bar[XB_TMO], 1u); break; } }
    }
    nloc = mine > 0u ? mine : 1u; nx = cnt > 0u ? cnt : 1u;
}

__device__ __forceinline__ void xcd_barrier(const XcdBarrier& b) {
    asm volatile("s_waitcnt vmcnt(0)" ::: "memory");
    __syncthreads();
    if (threadIdx.x == 0) {
        unsigned* bar = b.bar;
        __builtin_amdgcn_s_waitcnt(0);
        unsigned nloc = b.st[0], nx = b.st[1];
        if (nloc == 0u) { xcd_barrier_complete(bar, b.x, nloc, nx); b.st[0] = nloc; b.st[1] = nx; }
        const unsigned old = xb_add(&bar[XB_XSUB(b.x)], 1u);
        const unsigned gen = old / nloc;
        if (old + 1u == (gen + 1u) * nloc) {
            __builtin_amdgcn_fence(__ATOMIC_RELEASE, "agent");
            asm volatile("s_waitcnt vmcnt(0)" ::: "memory");
            const unsigned og = xb_add(&bar[XB_TOP], 1u);
            const unsigned tg = og / nx;
            if (og + 1u == (tg + 1u) * nx) xb_add(&bar[XB_TOPGEN], 1u);
            else XB_SPIN(xb_ld(&bar[XB_TOPGEN]) == tg, bar);
            __builtin_amdgcn_fence(__ATOMIC_ACQUIRE, "agent");
            xb_add(&bar[XB_XGEN(b.x)], 1u);
            asm volatile("s_waitcnt vmcnt(0)" ::: "memory");
        } else {
            XB_SPIN(xb_ld(&bar[XB_XGEN(b.x)]) == gen, bar);
            __builtin_amdgcn_fence(__ATOMIC_ACQUIRE, "agent");
            asm volatile("s_waitcnt vmcnt(0)" ::: "memory");
        }
    }
    __syncthreads();
}

struct Frame {
    LAS unsigned char* lds;
    gu32* ctl;
    int tid, lane, wave, G, gw, NGW;
    unsigned char* ws;
};
__device__ __forceinline__ float wave_sum(float v) {
#pragma unroll
    for (int o = 1; o < 64; o <<= 1) v += __shfl_xor(v, o);
    return v;
}
__device__ __forceinline__ void transpose_item(const float* W, int K, int N, bf16* WT, int rs, int off, LAS float* scr, int item, int lane) {
    const int nblk = N / 32, kb = item / nblk, nb = item % nblk, k0 = 64 * kb, n0 = 32 * nb;
#pragma unroll 8
    for (int i = 0; i < 32; ++i) { const int kk = 2 * i + (lane >> 5); scr[kk * 33 + (lane & 31)] = W[(size_t)(k0 + kk) * N + n0 + (lane & 31)]; }
    LDS_WAIT(); asm volatile("" ::: "memory");
    const int c = lane & 7;
#pragma unroll
    for (int j = 0; j < 4; ++j) { const int n = (lane >> 3) + 8 * j; const LAS float* s = scr + (8 * c) * 33 + n;
        v4u o; o.x = pk2(s[0 * 33], s[1 * 33]); o.y = pk2(s[2 * 33], s[3 * 33]); o.z = pk2(s[4 * 33], s[5 * 33]); o.w = pk2(s[6 * 33], s[7 * 33]);
        const int ng = n0 + n, drow = (ng >> 7) * rs + (ng & 127) + off;
        *(v4u*)(WT + (size_t)drow * K + k0 + 8 * c) = o; }
    LDS_WAIT(); asm volatile("" ::: "memory");
}
#define NI(K_, N_) (((K_) / 64) * ((N_) / 32))
__device__ __forceinline__ void quant_slab(Frame& F, const float* W, int N, signed char* WT, float* sB, int rs, int off, int slab) {
    constexpr int PITCH = 1028;
    LAS unsigned char* Tt = F.lds; LAS float* red = (LAS float*)(F.lds + 64 * PITCH);
    const int w = F.wave, l = F.lane, g = l >> 4, c4 = l & 15, n0 = slab * 64, nc = n0 + 4 * c4;
    const bool live = nc < N;
    f32x4 v[8][4];
#pragma unroll
    for (int P = 0; P < 8; ++P)
#pragma unroll
        for (int j = 0; j < 4; ++j) { const int r = 128 * P + 16 * w + 4 * g + j; v[P][j] = live ? *(const f32x4*)(W + (size_t)r * N + nc) : (f32x4){0.f, 0.f, 0.f, 0.f}; }
    f32x4 mx = (f32x4){0.f, 0.f, 0.f, 0.f};
#pragma unroll
    for (int P = 0; P < 8; ++P)
#pragma unroll
        for (int j = 0; j < 4; ++j) { mx.x = fmaxf(mx.x, fabsf(v[P][j].x)); mx.y = fmaxf(mx.y, fabsf(v[P][j].y)); mx.z = fmaxf(mx.z, fabsf(v[P][j].z)); mx.w = fmaxf(mx.w, fabsf(v[P][j].w)); }
#pragma unroll
    for (int o = 16; o < 64; o <<= 1) { mx.x = fmaxf(mx.x, __shfl_xor(mx.x, o)); mx.y = fmaxf(mx.y, __shfl_xor(mx.y, o)); mx.z = fmaxf(mx.z, __shfl_xor(mx.z, o)); mx.w = fmaxf(mx.w, __shfl_xor(mx.w, o)); }
    if (g == 0) *(LAS f32x4*)(red + w * 64 + 4 * c4) = mx;
    __syncthreads();
#pragma unroll
    for (int ww = 0; ww < 8; ++ww) { const f32x4 t = *(const LAS f32x4*)(red + ww * 64 + 4 * c4); mx.x = fmaxf(mx.x, t.x); mx.y = fmaxf(mx.y, t.y); mx.z = fmaxf(mx.z, t.z); mx.w = fmaxf(mx.w, t.w); }
    f32x4 inv; inv.x = mx.x > 0.f ? 127.f / mx.x : 0.f; inv.y = mx.y > 0.f ? 127.f / mx.y : 0.f; inv.z = mx.z > 0.f ? 127.f / mx.z : 0.f; inv.w = mx.w > 0.f ? 127.f / mx.w : 0.f;
#pragma unroll
    for (int P = 0; P < 8; ++P) {
        unsigned wd[4];
#pragma unroll
        for (int i = 0; i < 4; ++i) { const float s = (i == 0) ? inv.x : (i == 1) ? inv.y : (i == 2) ? inv.z : inv.w;
            const int q0 = (int)__builtin_rintf(v[P][0][i] * s), q1 = (int)__builtin_rintf(v[P][1][i] * s), q2 = (int)__builtin_rintf(v[P][2][i] * s), q3 = (int)__builtin_rintf(v[P][3][i] * s);
            wd[i] = (unsigned)(q0 & 0xff) | ((unsigned)(q1 & 0xff) << 8) | ((unsigned)(q2 & 0xff) << 16) | ((unsigned)(q3 & 0xff) << 24); }
#pragma unroll
        for (int i = 0; i < 4; ++i) *(LAS unsigned*)(Tt + (4 * c4 + i) * PITCH + 128 * P + 16 * w + 4 * g) = wd[i];
    }
    if (w == 0 && g == 0 && live) {
#pragma unroll
        for (int i = 0; i < 4; ++i) { const int ng = nc + i, drow = (ng >> 7) * rs + (ng & 127) + off; sB[drow] = ((i == 0) ? mx.x : (i == 1) ? mx.y : (i == 2) ? mx.z : mx.w) * (1.f / 127.f); }
    }
    __syncthreads();
#pragma unroll
    for (int k = 0; k < 8; ++k) { const int n = 8 * w + k, ng = n0 + n;
        if (ng < N) { const LAS unsigned* sp = (const LAS unsigned*)(Tt + n * PITCH + 16 * l); const v4u o = (v4u){sp[0], sp[1], sp[2], sp[3]};
            const int drow = (ng >> 7) * rs + (ng & 127) + off; *((v4u*)(WT + (size_t)drow * D) + l) = o; } }
    __syncthreads();
}
__device__ __forceinline__ void quant_small(Frame& F, const float* const* in) {
    signed char* WB = (signed char*)(F.ws + WS_WSM); float* SB = (float*)(F.ws + WS_TAB + TAB_SB);
    constexpr int NSL = 2 * 20 + 48 + 11 + 4 * 44;
    for (int it = blockIdx.x; it < NSL; it += F.G) {
        int r = it; bool found = false; const float* W = nullptr; signed char* WT = nullptr; int N = 0, rs = 128, off = 0, so = 0;
#define JOB(Wp, WTp, N_, RS, OFF, SO) if (!found) { const int ni = ((N_) + 63) / 64; if (r < ni) { W = (Wp); WT = (WTp); N = (N_); rs = (RS); off = (OFF); so = (SO); found = true; } else r -= ni; }
        JOB(in[5], WB + B_SWAQKV, SWA_N, 128, 0, SBO_SWAQKV)
        JOB(in[5] + (size_t)D * SWA_N, WB + B_SWAQKV + (size_t)SWA_N * D, SWA_N, 128, 0, SBO_SWAQKV + SWA_N)
        JOB(in[9], WB + B_SBQKV, SB_N, 128, 0, SBO_SBQKV)
        JOB(in[11], WB + B_MLAD, 672, 128, 0, SBO_MLAD)
        JOB(in[17], WB + B_FFNGU, FFN, 256, 0, SBO_FFNGU)
        JOB(in[18], WB + B_FFNGU, FFN, 256, 128, SBO_FFNGU)
        JOB(in[17] + (size_t)D * FFN, WB + B_FFNGU + (size_t)2 * FFN * D, FFN, 256, 0, SBO_FFNGU + 2 * FFN)
        JOB(in[18] + (size_t)D * FFN, WB + B_FFNGU + (size_t)2 * FFN * D, FFN, 256, 128, SBO_FFNGU + 2 * FFN)
#undef JOB
        if (found) quant_slab(F, W, N, WT, SB + so, rs, off, r);
    }
}
__device__ __forceinline__ void quant_moe_gu(Frame& F, const float* wg, const float* wu, int f) {
    signed char* WM = (signed char*)(F.ws + WS_WMOE); float* SB = (float*)(F.ws + WS_TAB + TAB_SB) + SBO_MOE + f * 57344;
    constexpr int PER = EDIM / 64;
    for (int it = blockIdx.x; it < 16 * PER; it += F.G) {
        const int which = it / PER, r = it % PER, e = which >> 1, up = which & 1;
        quant_slab(F, (up ? wu : wg) + (size_t)e * D * EDIM, EDIM, WM + (size_t)e * B_MOEGU_E, SB + e * 7168, 256, up * 128, r);
    }
}
__device__ __forceinline__ void convert_small_bf16(Frame& F, const float* const* in) {
    LAS float* scr = (LAS float*)(F.lds + F.wave * 16384);
    unsigned char* WB = F.ws + WS_WSM;
    constexpr int NITEMS = 4 * NI(D, D) + NI(MLA_QR, MLA_UQN) + NI(MLA_KVR, MLA_UKVN) + 2 * NI(FFN, D);
    for (int it = F.gw; it < NITEMS; it += F.NGW) {
        int r = it; bool found = false; const float* W = nullptr; bf16* WT = nullptr; int K = 0, N = 0;
#define JOB(Wp, WTp, K_, N_) if (!found) { const int ni = NI(K_, N_); if (r < ni) { W = (Wp); WT = (bf16*)(WTp); K = (K_); N = (N_); found = true; } else r -= ni; }
        JOB(in[8], WB + B_SWAO, D, D)
        JOB(in[8] + (size_t)D * D, WB + B_SWAO + (size_t)D * D * 2, D, D)
        JOB(in[10], WB + B_SBO, D, D)
        JOB(in[16], WB + B_MLAO, D, D)
        JOB(in[13], WB + B_MLAUQ, MLA_QR, MLA_UQN)
        JOB(in[15], WB + B_MLAUKV, MLA_KVR, MLA_UKVN)
        JOB(in[19], WB + B_FFND, FFN, D)
        JOB(in[19] + (size_t)FFN * D, WB + B_FFND + (size_t)D * FFN * 2, FFN, D)
#undef JOB
        if (found) transpose_item(W, K, N, WT, 128, 0, scr, r, F.lane);
    }
    for (int i = F.gw * 64 + F.lane; i < SEQ * 16; i += F.NGW * 64) {
        const int pos = i >> 4, fi = i & 15;
        const double inv = exp2(-(double)fi * (13.287712379549449 / 16.0));
        const double turns = (double)pos * inv * 0.15915494309189535;
        const float fr = (float)(turns - floor(turns));
        ((float*)(F.ws + WS_TAB + TAB_COS))[i] = __builtin_amdgcn_cosf(fr);
        ((float*)(F.ws + WS_TAB + TAB_SIN))[i] = __builtin_amdgcn_sinf(fr);
    }
}
__device__ __forceinline__ void convert_moe_down(Frame& F, const float* wd) {
    LAS float* scr = (LAS float*)(F.lds + F.wave * 16384);
    constexpr int PER = NI(EDIM, D);
    for (int it = F.gw; it < 8 * PER; it += F.NGW) { const int e = it / PER, r = it % PER;
        transpose_item(wd + (size_t)e * EDIM * D, EDIM, D, (bf16*)(F.ws + WS_WMOE + B_MOED + (size_t)e * B_MOED_E), 128, 0, scr, r, F.lane); }
}
#undef NI
__device__ __forceinline__ void zero_mlad_pad(Frame& F) {
    for (int i = F.gw * 64 + F.lane; i < 96 * 1024 / 16; i += F.NGW * 64) *(v4u*)(F.ws + WS_WSM + B_MLAD + (size_t)672 * D + (size_t)i * 16) = (v4u){0u, 0u, 0u, 0u};
    float* SB = (float*)(F.ws + WS_TAB + TAB_SB) + SBO_MLAD;
    for (int i = F.gw * 64 + F.lane; i < 96; i += F.NGW * 64) SB[672 + i] = 0.f;
}
__device__ __forceinline__ void quant_row_store(const f32x4 (&v)[4], signed char* h8row, float* sa, int lane) {
    float mx = 0.f;
#pragma unroll
    for (int j = 0; j < 4; ++j) mx = fmaxf(mx, fmaxf(fmaxf(fabsf(v[j].x), fabsf(v[j].y)), fmaxf(fabsf(v[j].z), fabsf(v[j].w))));
#pragma unroll
    for (int o = 1; o < 64; o <<= 1) mx = fmaxf(mx, __shfl_xor(mx, o));
    const float inv = mx > 0.f ? 127.f / mx : 0.f;
    unsigned* o4 = (unsigned*)h8row + lane;
#pragma unroll
    for (int j = 0; j < 4; ++j) { const int q0 = (int)__builtin_rintf(v[j].x * inv), q1 = (int)__builtin_rintf(v[j].y * inv), q2 = (int)__builtin_rintf(v[j].z * inv), q3 = (int)__builtin_rintf(v[j].w * inv);
        o4[64 * j] = (unsigned)(q0 & 0xff) | ((unsigned)(q1 & 0xff) << 8) | ((unsigned)(q2 & 0xff) << 16) | ((unsigned)(q3 & 0xff) << 24); }
    if (lane == 0) *sa = mx * (1.f / 127.f);
}
__device__ __forceinline__ void norm_phase(Frame& F, const float* src, const bf16* delta, float* xout, const float* g, signed char* h8, float* sa) {
    f32x4 gv[4];
#pragma unroll
    for (int j = 0; j < 4; ++j) gv[j] = ((const f32x4*)g)[F.lane + 64 * j];
    for (int m = F.gw; m < T; m += F.NGW) {
        const f32x4* xr = (const f32x4*)(src + (size_t)m * D) + F.lane;
        f32x4 v[4]; float ss = 0.f;
#pragma unroll
        for (int j = 0; j < 4; ++j) v[j] = xr[64 * j];
        if (delta) { const v2u* dr = (const v2u*)(delta + (size_t)m * D) + F.lane; f32x4* xo = (f32x4*)(xout + (size_t)m * D) + F.lane;
#pragma unroll
            for (int j = 0; j < 4; ++j) { const v2u a = dr[64 * j]; v[j].x += bflo(a.x); v[j].y += bfhi(a.x); v[j].z += bflo(a.y); v[j].w += bfhi(a.y); xo[64 * j] = v[j]; } }
#pragma unroll
        for (int j = 0; j < 4; ++j) ss += (v[j].x * v[j].x + v[j].y * v[j].y) + (v[j].z * v[j].z + v[j].w * v[j].w);
        const float rstd = rsqrtf(wave_sum(ss) * (1.f / D) + RMS_EPS);
#pragma unroll
        for (int j = 0; j < 4; ++j) v[j] = v[j] * rstd * gv[j];
        quant_row_store(v, h8 + (size_t)m * D, sa + m, F.lane);
    }
}
__device__ __forceinline__ void norm_route_phase(Frame& F, float* src, const bf16* delta, const float* g, signed char* h8, float* sa, const float* router, int layer) {
    LAS float* Rt = (LAS float*)F.lds;
    for (int i = F.tid; i < D * NEXP; i += NWAVES * 64) { const int k = i >> 3, e = i & 7; Rt[e * D + k] = router[i]; }
    __syncthreads();
    f32x4 gv[4];
#pragma unroll
    for (int j = 0; j < 4; ++j) gv[j] = ((const f32x4*)g)[F.lane + 64 * j];
    int* tok_e = (int*)(F.ws + WS_TAB + TAB_TOKE); f32x2* tok_g = (f32x2*)(F.ws + WS_TAB + TAB_TOKG);
    unsigned long long cnt = 0ull;
    for (int m = F.gw; m < T; m += F.NGW) {
        f32x4* xr = (f32x4*)(src + (size_t)m * D) + F.lane;
        f32x4 v[4]; float ss = 0.f;
#pragma unroll
        for (int j = 0; j < 4; ++j) v[j] = xr[64 * j];
        if (delta) { const v2u* dr = (const v2u*)(delta + (size_t)m * D) + F.lane;
#pragma unroll
            for (int j = 0; j < 4; ++j) { const v2u a = dr[64 * j]; v[j].x += bflo(a.x); v[j].y += bfhi(a.x); v[j].z += bflo(a.y); v[j].w += bfhi(a.y); xr[64 * j] = v[j]; } }
#pragma unroll
        for (int j = 0; j < 4; ++j) ss += (v[j].x * v[j].x + v[j].y * v[j].y) + (v[j].z * v[j].z + v[j].w * v[j].w);
        const float rstd = rsqrtf(wave_sum(ss) * (1.f / D) + RMS_EPS);
#pragma unroll
        for (int j = 0; j < 4; ++j) v[j] = v[j] * rstd * gv[j];
        quant_row_store(v, h8 + (size_t)m * D, sa + m, F.lane);
        float lg[8];
#pragma unroll
        for (int e = 0; e < 8; ++e) { float a = 0.f;
#pragma unroll
            for (int j = 0; j < 4; ++j) { const f32x4 r = *(const LAS f32x4*)(Rt + e * D + 256 * j + 4 * F.lane); a += (v[j].x * r.x + v[j].y * r.y) + (v[j].z * r.z + v[j].w * r.w); }
            lg[e] = wave_sum(a); }
        int e1 = 0; float v1 = lg[0];
#pragma unroll
        for (int e = 1; e < 8; ++e) if (lg[e] > v1) { v1 = lg[e]; e1 = e; }
        int e2 = -1; float v2 = -3.0e38f;
#pragma unroll
        for (int e = 0; e < 8; ++e) if (e != e1 && lg[e] > v2) { v2 = lg[e]; e2 = e; }
        const float g1 = 1.f / (1.f + __expf(v2 - v1)), g2 = 1.f - g1;
        if (F.lane == 0) { tok_e[m] = e1 | (e2 << 8); tok_g[m] = (f32x2){g1, g2}; }
        cnt += (1ull << (8 * e1)) + (1ull << (8 * e2));
    }
    if (F.lane < 8) { const unsigned c = (unsigned)(cnt >> (8 * F.lane)) & 0xffu; if (c) __hip_atomic_fetch_add((unsigned*)(F.ctl + CW_CNT + 64 * layer) + F.lane, c, RLX_AGENT); }
    if (F.lane == 0) ((unsigned long long*)(F.ws + WS_TAB + TAB_WCNT))[layer * 4096 + F.gw] = cnt;
    __syncthreads();
}
struct MoeLayout { int poff[8]; int tp[9]; };
__device__ __forceinline__ MoeLayout moe_layout(Frame& F, int layer) {
    MoeLayout L; int acc = 0; L.tp[0] = 0;
#pragma unroll
    for (int e = 0; e < 8; ++e) { const int c = (int)__builtin_amdgcn_readfirstlane(__hip_atomic_load((unsigned*)(F.ctl + CW_CNT + 64 * layer) + e, RLX_AGENT)); L.poff[e] = acc * 256; acc += (c + 255) >> 8; L.tp[e + 1] = acc; }
    return L;
}
__device__ __forceinline__ void route_assign_phase(Frame& F, const signed char* h8, const float* sa, signed char* hperm, float* sap, int layer) {
    const MoeLayout L = moe_layout(F, layer);
    const int* tok_e = (const int*)(F.ws + WS_TAB + TAB_TOKE); int* tok_slot = (int*)(F.ws + WS_TAB + TAB_SLOT);
    const unsigned long long* wcnt = (const unsigned long long*)(F.ws + WS_TAB + TAB_WCNT) + layer * 4096;
    int base[8];
#pragma unroll
    for (int e = 0; e < 8; ++e) base[e] = 0;
    for (int g2 = F.lane; g2 < F.gw; g2 += 64) { const unsigned long long c = wcnt[g2];
#pragma unroll
        for (int e = 0; e < 8; ++e) base[e] += (int)((c >> (8 * e)) & 0xffull); }
#pragma unroll
    for (int e = 0; e < 8; ++e) { int v = base[e];
#pragma unroll
        for (int o = 1; o < 64; o <<= 1) v += __shfl_xor(v, o);
        base[e] = L.poff[e] + v; }
    const int nmine = (T - F.gw + F.NGW - 1) / F.NGW;
    for (int k0 = 0; k0 < nmine; k0 += 16) {
        const int kk = k0 + (F.lane & 15), k = (F.lane >> 4) & 1;
        const bool act = F.lane < 32 && kk < nmine;
        const int tok = act ? F.gw + kk * F.NGW : 0;
        int my_e = 255;
        if (act) my_e = (tok_e[tok] >> (8 * k)) & 0xff;
        int slot = 0;
#pragma unroll
        for (int e = 0; e < 8; ++e) {
            const unsigned long long m1 = __ballot(my_e == e);
            const unsigned lo = (unsigned)m1 & 0xffffu, hi = ((unsigned)m1 >> 16) & 0xffffu;
            const unsigned r = F.lane & 15, below = (1u << r) - 1u;
            const int rank = __popc(lo & below) + __popc(hi & below);
            if (my_e == e) slot = base[e] + rank;
            base[e] += __popc(lo) + __popc(hi);
        }
        if (act) { tok_slot[tok * 2 + k] = slot; sap[slot] = sa[tok]; }
#pragma unroll 8
        for (int j = 0; j < 32; ++j) {
            const int tj = __shfl(tok, j), sj = __shfl(slot, j), aj = __shfl((int)act, j);
            if (aj) *((v4u*)(hperm + (size_t)sj * D) + F.lane) = *((const v4u*)(h8 + (size_t)tj * D) + F.lane);
        }
    }
}
template <bool FINAL>
__device__ __forceinline__ void combine_norm_phase(Frame& F, float* xres, const bf16* y, const float* g, signed char* h8, float* sa) {
    const bf16* yp = (const bf16*)(F.ws + WS_YP);
    f32x4 gv[4];
#pragma unroll
    for (int j = 0; j < 4; ++j) gv[j] = ((const f32x4*)g)[F.lane + 64 * j];
    const i32x2* tok_slot = (const i32x2*)(F.ws + WS_TAB + TAB_SLOT); const f32x2* tok_g = (const f32x2*)(F.ws + WS_TAB + TAB_TOKG);
    for (int m = F.gw; m < T; m += F.NGW) {
        const i32x2 sl = tok_slot[m]; const f32x2 gg = tok_g[m];
        f32x4* xr = (f32x4*)(xres + (size_t)m * D) + F.lane;
        f32x4 v[4]; float ss = 0.f;
#pragma unroll
        for (int j = 0; j < 4; ++j) v[j] = xr[64 * j];
#pragma unroll
        for (int k = 0; k < 2; ++k) { const int slot = k ? sl.y : sl.x; const float gk = k ? gg.y : gg.x;
            if (slot < 65536) { const v2u* yr = (const v2u*)(y + (size_t)slot * D) + F.lane;
#pragma unroll
                for (int j = 0; j < 4; ++j) { const v2u a = yr[64 * j]; v[j].x += gk * bflo(a.x); v[j].y += gk * bfhi(a.x); v[j].z += gk * bflo(a.y); v[j].w += gk * bfhi(a.y); } }
            else { f32x4 t[4];
#pragma unroll
                for (int j = 0; j < 4; ++j) t[j] = (f32x4){0.f, 0.f, 0.f, 0.f};
                for (int p = 0; p < 7; ++p) { const v2u* yr = (const v2u*)(yp + (size_t)p * YP_ELEMS + (size_t)(slot - 65536) * D) + F.lane;
#pragma unroll
                    for (int j = 0; j < 4; ++j) { const v2u a = yr[64 * j]; t[j].x += bflo(a.x); t[j].y += bfhi(a.x); t[j].z += bflo(a.y); t[j].w += bfhi(a.y); } }
#pragma unroll
                for (int j = 0; j < 4; ++j) v[j] = v[j] + t[j] * gk; } }
#pragma unroll
        for (int j = 0; j < 4; ++j) ss += (v[j].x * v[j].x + v[j].y * v[j].y) + (v[j].z * v[j].z + v[j].w * v[j].w);
        const float rstd = rsqrtf(wave_sum(ss) * (1.f / D) + RMS_EPS);
        if (FINAL) {
#pragma unroll
            for (int j = 0; j < 4; ++j) xr[64 * j] = v[j] * rstd * gv[j];
        } else {
#pragma unroll
            for (int j = 0; j < 4; ++j) { xr[64 * j] = v[j]; v[j] = v[j] * rstd * gv[j]; }
            quant_row_store(v, h8 + (size_t)m * D, sa + m, F.lane);
        }
    }
}
__device__ __forceinline__ void mla_cnorm_phase(Frame& F, const bf16* c, const float* qn, const float* kvn, bf16* cqn, bf16* ckvn, bf16* krope) {
    const float* cosT = (const float*)(F.ws + WS_TAB + TAB_COS); const float* sinT = (const float*)(F.ws + WS_TAB + TAB_SIN);
    float gq[6], gk[4];
#pragma unroll
    for (int j = 0; j < 6; ++j) gq[j] = qn[F.lane + 64 * j];
#pragma unroll
    for (int j = 0; j < 4; ++j) gk[j] = kvn[F.lane + 64 * j];
    for (int m = F.gw; m < T; m += F.NGW) {
        const bf16* cr = c + (size_t)m * MLA_DN;
        float a[6], b[4]; float sa = 0.f, sb = 0.f;
#pragma unroll
        for (int j = 0; j < 6; ++j) { a[j] = bflo((unsigned)cr[F.lane + 64 * j]); sa += a[j] * a[j]; }
#pragma unroll
        for (int j = 0; j < 4; ++j) { b[j] = bflo((unsigned)cr[MLA_QR + F.lane + 64 * j]); sb += b[j] * b[j]; }
        const float kr = bflo((unsigned)cr[MLA_QR + MLA_KVR + (F.lane & 31)]);
        const float ra = rsqrtf(wave_sum(sa) * (1.f / MLA_QR) + RMS_EPS), rb = rsqrtf(wave_sum(sb) * (1.f / MLA_KVR) + RMS_EPS);
#pragma unroll
        for (int j = 0; j < 6; ++j) cqn[(size_t)m * MLA_QR + F.lane + 64 * j] = (bf16)f2bf(a[j] * ra * gq[j]);
#pragma unroll
        for (int j = 0; j < 4; ++j) ckvn[(size_t)m * MLA_KVR + F.lane + 64 * j] = (bf16)f2bf(b[j] * rb * gk[j]);
        const float pr = __shfl_xor(kr, 16);
        const int pos = m & (SEQ - 1), i = F.lane & 15; const float cs = cosT[pos * 16 + i], sn = sinT[pos * 16 + i];
        const float ro = ((F.lane & 16) == 0) ? kr * cs - pr * sn : pr * sn + kr * cs;
        if (F.lane < 32) krope[(size_t)m * 32 + F.lane] = (bf16)f2bf(ro);
    }
}

struct Args { const float* in[24]; float* out; unsigned char* ws; int ph_lo, ph_hi; };
constexpr int LDS_BYTES = 147456, RING_BYTES = 131072, MISC_OFF = RING_BYTES + 320;

__global__ void __launch_bounds__(NWAVES * 64, 2) trunk_fwd(Args args) {
    extern __shared__ __attribute__((aligned(16))) unsigned char lds[];
    Frame F;
    F.lds = (LAS unsigned char*)lds; F.ws = args.ws; F.ctl = (gu32*)(args.ws + WS_CTL);
    F.tid = threadIdx.x; F.lane = F.tid & 63; F.wave = __builtin_amdgcn_readfirstlane(F.tid >> 6); F.G = gridDim.x;
    F.gw = blockIdx.x * NWAVES + F.wave; F.NGW = F.G * NWAVES;
    volatile LAS unsigned* MISC = (volatile LAS unsigned*)(F.lds + MISC_OFF);
    for (int u = F.tid; u < (LDS_BYTES - RING_BYTES) / 4; u += NWAVES * 64) ((LAS unsigned*)(F.lds + RING_BYTES))[u] = 0u;
    __syncthreads();
    const int lo = args.ph_lo, hi = args.ph_hi;
    XcdBarrier bar; bar.bar = (unsigned*)(F.ctl + CW_BAR); bar.x = 0; bar.st = nullptr;
    if (hi - lo > 1) bar = xcd_barrier_post((unsigned*)(F.ctl + CW_BAR), MISC + 8);
#define IN(k) (lo <= (k) && (k) < hi)
#define RUN(k) if (IN(k)) _Pragma("unroll") for (int rep_ = 0; rep_ < ((((k) == PROBE_A) || ((k) == PROBE_B) || ((k) == PROBE_C)) ? 2 : 1); ++rep_)
#define SEAM(k) do { if (IN(k) && IN((k) + 1)) xcd_barrier(bar); } while (0)
    const float* const* in = args.in;
    unsigned char* ws = args.ws;
    float* xres = args.out;
    unsigned char* WB = ws + WS_WSM; unsigned char* WM = ws + WS_WMOE;
    bf16* H = (bf16*)(ws + WS_H); signed char* H8 = (signed char*)(ws + WS_H);
    float* SA = (float*)(ws + WS_TAB + TAB_SA); float* SAP = (float*)(ws + WS_TAB + TAB_SAP); const float* SB = (const float*)(ws + WS_TAB + TAB_SB);
    unsigned char* scr = ws + WS_SCR; bf16* DELTA = (bf16*)(scr + SC_DELTA);
    const float* cosT = (const float*)(ws + WS_TAB + TAB_COS); const float* sinT = (const float*)(ws + WS_TAB + TAB_SIN);
    LAS unsigned char* ring = F.lds;
    const int c = (int)blockIdx.x;

#define GEMM_BF16S_I8(Btp, N_, Op, ldc_, biasp, nsc_, sc_, sbo_) do { pg8::Gemm g{(const pg8::bf16_t*)H8, (const pg8::bf16_t*)(Btp), T, (N_), D, D}; pg8::StaticOrder S; S.init(T, (N_), F.G, c); \
        pg8::EpiBf16S E{(pg8::bf16_t*)(Op), (ldc_), (biasp), (nsc_), (sc_), SA, SB + (sbo_)}; pg8::gemm_phase<pg8::EpiBf16S, pg8::StaticOrder, true, true, true>(ring, g, S, E); } while (0)
#define GEMM_BF16S(Ap, Btp, M_, N_, K_, Op, ldc_, nsc_, sc_) do { pg8::Gemm g{(const pg8::bf16_t*)(Ap), (const pg8::bf16_t*)(Btp), (M_), (N_), (K_), (K_)}; pg8::StaticOrder S; S.init((M_), (N_), F.G, c); \
        pg8::EpiBf16S E{(pg8::bf16_t*)(Op), (ldc_), nullptr, (nsc_), (sc_), nullptr, nullptr}; pg8::gemm_phase<pg8::EpiBf16S, pg8::StaticOrder, true, true, false>(ring, g, S, E); } while (0)
#define GEMM_RES(Ap, Btp, K_, basep) do { pg8::Gemm g{(const pg8::bf16_t*)(Ap), (const pg8::bf16_t*)(Btp), T, D, (K_), (K_)}; pg8::StaticOrder S; S.init(T, D, F.G, c); \
        pg8::EpiResF32 E{(basep), xres, D}; pg8::gemm_phase<pg8::EpiResF32, pg8::StaticOrder, true, true, false>(ring, g, S, E); } while (0)
#define GEMM_SWIGLU_I8(Btp, N2_, Op, sbo_) do { pg8::Gemm g{(const pg8::bf16_t*)H8, (const pg8::bf16_t*)(Btp), T, (N2_), D, D}; pg8::StaticOrder S; S.init(T, (N2_), F.G, c); \
        pg8::EpiSwiGLU E{(pg8::bf16_t*)(Op), (N2_) / 2, SA, SB + (sbo_)}; pg8::gemm_phase<pg8::EpiSwiGLU, pg8::StaticOrder, true, true, true>(ring, g, S, E); } while (0)
#define ATTN(MODE_, AA) do { if ((NAIVE_ATTN >> (MODE_)) & 1) att::attn_naive<MODE_>(AA, F.G, c); else att::attn_phase<MODE_>((LAS char*)ring, AA, F.G, c); } while (0)
#define MOE_GEMMS(layer_, k1, k2) \
    RUN(k1) { const MoeLayout ML = moe_layout(F, (layer_)); pg8::Gemm g{(const pg8::bf16_t*)(scr + SC_HPERM), (const pg8::bf16_t*)WM, PMAX, 2 * EDIM, D, D}; \
        pg8::GroupedOrder S; S.nM = ML.tp[8]; S.nN = 2 * EDIM / 256; S.nwg = S.nM * S.nN; S.G = F.G; S.c = c; S.tp1 = ML.tp[1]; S.tp2 = ML.tp[2]; S.tp3 = ML.tp[3]; S.tp4 = ML.tp[4]; S.tp5 = ML.tp[5]; S.tp6 = ML.tp[6]; S.tp7 = ML.tp[7]; S.estride = (long)B_MOEGU_E; S.sstride = 2 * EDIM; \
        pg8::EpiSwiGLU E{(pg8::bf16_t*)(scr + SC_MACT), EDIM, SAP, SB + SBO_MOE + (layer_) * 57344}; pg8::gemm_phase<pg8::EpiSwiGLU, pg8::GroupedOrder, true, true, true>(ring, g, S, E); } \
    SEAM(k1); \
    RUN(k2) { const MoeLayout ML = moe_layout(F, (layer_)); \
        { pg8::Gemm g{(const pg8::bf16_t*)(scr + SC_MACT), (const pg8::bf16_t*)(WM + B_MOED), PMAX, D, EDIM, EDIM}; \
          pg8::GroupedOrder S; S.nM = ML.tp[8] < 256 ? ML.tp[8] : 256; S.nN = D / 256; S.nwg = S.nM * S.nN; S.G = F.G; S.c = c; S.tp1 = ML.tp[1]; S.tp2 = ML.tp[2]; S.tp3 = ML.tp[3]; S.tp4 = ML.tp[4]; S.tp5 = ML.tp[5]; S.tp6 = ML.tp[6]; S.tp7 = ML.tp[7]; S.estride = (long)B_MOED_E; S.sstride = 0; \
          pg8::EpiBf16S E{(pg8::bf16_t*)(scr + SC_HPERM), D, nullptr, 0, 1.f, nullptr, nullptr}; pg8::gemm_phase<pg8::EpiBf16S, pg8::GroupedOrder, true, true, false>(ring, g, S, E); } \
        if (ML.tp[8] > 256) { pg8::Gemm g{(const pg8::bf16_t*)(scr + SC_MACT), (const pg8::bf16_t*)(WM + B_MOED), PMAX, D, 512, EDIM}; \
          pg8::SplitKOrder S; S.nrem = ML.tp[8] - 256; S.G = F.G; S.c = c; S.tp1 = ML.tp[1]; S.tp2 = ML.tp[2]; S.tp3 = ML.tp[3]; S.tp4 = ML.tp[4]; S.tp5 = ML.tp[5]; S.tp6 = ML.tp[6]; S.tp7 = ML.tp[7]; S.estride = (long)B_MOED_E; S.pstride = (long)YP_ELEMS; \
          pg8::EpiBf16S E{(pg8::bf16_t*)(ws + WS_YP), D, nullptr, 0, 1.f, nullptr, nullptr}; pg8::gemm_phase<pg8::EpiBf16S, pg8::SplitKOrder, true, true, false>(ring, g, S, E); } } \
    SEAM(k2);

    RUN(0) { quant_small(F, in); quant_moe_gu(F, in[21], in[22], 0); convert_small_bf16(F, in); convert_moe_down(F, in[23]); zero_mlad_pad(F); norm_phase(F, in[0], nullptr, nullptr, in[2], H8, SA); }
    SEAM(0);
    RUN(2) GEMM_BF16S_I8(WB + B_SWAQKV, SWA_N, scr + SC_QKV, SWA_N, in[6], 4, 0.125f * LOG2E, SBO_SWAQKV);
    SEAM(2);
    RUN(3) { const bf16* QKV = (const bf16*)(scr + SC_QKV); att::Args A{QKV, SWA_N, 64, QKV + 1024, SWA_N, 64, nullptr, QKV + 1152, SWA_N, 64, H, cosT, sinT, in[1], in[7]}; ATTN(0, A); }
    SEAM(3);
    RUN(4) GEMM_RES(H, WB + B_SWAO, D, in[0]);
    SEAM(4);
    RUN(5) norm_phase(F, xres, nullptr, nullptr, in[3], H8, SA);
    SEAM(5);
    RUN(6) GEMM_SWIGLU_I8(WB + B_FFNGU, 2 * FFN, scr + SC_ACT, SBO_FFNGU);
    SEAM(6);
    RUN(7) GEMM_RES(scr + SC_ACT, WB + B_FFND, FFN, xres);
    SEAM(7);
    RUN(8) norm_phase(F, xres, nullptr, nullptr, in[2] + D, H8, SA);
    SEAM(8);
    RUN(9) GEMM_BF16S_I8(WB + B_SBQKV, SB_N, scr + SC_QKV, SB_N, nullptr, 4, 0.125f * LOG2E, SBO_SBQKV);
    SEAM(9);
    RUN(10) { const bf16* QKV = (const bf16*)(scr + SC_QKV); att::Args A{QKV, SB_N, 64, QKV + 1024, SB_N, 64, nullptr, QKV + 2048, SB_N, 64, H, cosT, sinT, in[1], in[7]}; ATTN(1, A); }
    SEAM(10);
    RUN(11) GEMM_RES(H, WB + B_SBO, D, xres);
    SEAM(11);
    RUN(12) norm_route_phase(F, xres, nullptr, in[3] + D, H8, SA, in[20], 0);
    SEAM(12);
    RUN(13) route_assign_phase(F, H8, SA, (signed char*)(scr + SC_HPERM), SAP, 0);
    SEAM(13);
    MOE_GEMMS(0, 14, 15)
    RUN(16) { combine_norm_phase<false>(F, xres, (const bf16*)(scr + SC_HPERM), in[2] + 2 * D, H8, SA);
              quant_moe_gu(F, in[21] + (size_t)8 * D * EDIM, in[22] + (size_t)8 * D * EDIM, 1); convert_moe_down(F, in[23] + (size_t)8 * EDIM * D); }
    SEAM(16);
    RUN(17) GEMM_BF16S_I8(WB + B_MLAD, MLA_DN, scr + SC_C, MLA_DN, nullptr, 0, 1.f, SBO_MLAD);
    SEAM(17);
    RUN(18) mla_cnorm_phase(F, (const bf16*)(scr + SC_C), in[12], in[14], (bf16*)(scr + SC_CQN), (bf16*)(scr + SC_CKVN), (bf16*)(scr + SC_KROPE));
    SEAM(18);
    RUN(19) { GEMM_BF16S(scr + SC_CQN, WB + B_MLAUQ, T, MLA_UQN, MLA_QR, scr + SC_QM, MLA_UQN, 6, 0.10206207261596577f * LOG2E);
              GEMM_BF16S(scr + SC_CKVN, WB + B_MLAUKV, T, MLA_UKVN, MLA_KVR, scr + SC_KVM, MLA_UKVN, 0, 1.f); }
    SEAM(19);
    RUN(20) { const bf16* KV = (const bf16*)(scr + SC_KVM); att::Args A{(const bf16*)(scr + SC_QM), MLA_UQN, 96, KV, MLA_UKVN, 128, (const bf16*)(scr + SC_KROPE), KV + 64, MLA_UKVN, 128, H, cosT, sinT, in[1], in[7]}; ATTN(2, A); }
    SEAM(20);
    RUN(21) GEMM_RES(H, WB + B_MLAO, D, xres);
    SEAM(21);
    RUN(22) norm_phase(F, xres, nullptr, nullptr, in[3] + 2 * D, H8, SA);
    SEAM(22);
    RUN(23) GEMM_SWIGLU_I8(WB + B_FFNGU + (size_t)2 * FFN * D, 2 * FFN, scr + SC_ACT, SBO_FFNGU + 2 * FFN);
    SEAM(23);
    RUN(24) GEMM_RES(scr + SC_ACT, WB + B_FFND + (size_t)D * FFN * 2, FFN, xres);
    SEAM(24);
    RUN(25) norm_phase(F, xres, nullptr, nullptr, in[2] + 3 * D, H8, SA);
    SEAM(25);
    RUN(26) GEMM_BF16S_I8(WB + B_SWAQKV + (size_t)SWA_N * D, SWA_N, scr + SC_QKV, SWA_N, in[6] + SWA_N, 4, 0.125f * LOG2E, SBO_SWAQKV + SWA_N);
    SEAM(26);
    RUN(27) { const bf16* QKV = (const bf16*)(scr + SC_QKV); att::Args A{QKV, SWA_N, 64, QKV + 1024, SWA_N, 64, nullptr, QKV + 1152, SWA_N, 64, H, cosT, sinT, in[1], in[7] + 16}; ATTN(0, A); }
    SEAM(27);
    RUN(28) GEMM_RES(H, WB + B_SWAO + (size_t)D * D * 2, D, xres);
    SEAM(28);
    RUN(29) norm_route_phase(F, xres, nullptr, in[3] + 3 * D, H8, SA, in[20] + D * NEXP, 1);
    SEAM(29);
    RUN(30) route_assign_phase(F, H8, SA, (signed char*)(scr + SC_HPERM), SAP, 1);
    SEAM(30);
    MOE_GEMMS(1, 31, 32)
    RUN(33) combine_norm_phase<true>(F, xres, (const bf16*)(scr + SC_HPERM), in[4], nullptr, nullptr);
#undef IN
#undef RUN
#undef SEAM
}

extern "C" void kernel_launch(void* const* d_in, const int* in_sizes, int n_in, void* d_out, int out_size, void* d_ws, size_t ws_size, hipStream_t stream) {
    static int grid = 0;
    if (grid == 0) {
        if (n_in != 24 || in_sizes[0] != T * D || out_size != T * D || ws_size < WS_END) { fprintf(stderr, "kernel_launch: unexpected problem (n_in %d, in0 %d, out %d, ws %zu < %zu); nothing launched\n", n_in, n_in > 0 ? in_sizes[0] : -1, out_size, ws_size, (size_t)WS_END); grid = -1; return; }
        int dev = 0, cus = 0, per_cu = 0;
        if (hipGetDevice(&dev) != hipSuccess || hipDeviceGetAttribute(&cus, hipDeviceAttributeMultiprocessorCount, dev) != hipSuccess) { grid = -1; return; }
        if (hipFuncSetAttribute((const void*)trunk_fwd, hipFuncAttributeMaxDynamicSharedMemorySize, LDS_BYTES) != hipSuccess) { fprintf(stderr, "kernel_launch: hipFuncSetAttribute failed\n"); grid = -1; return; }
        if (hipOccupancyMaxActiveBlocksPerMultiprocessor(&per_cu, (const void*)trunk_fwd, NWAVES * 64, LDS_BYTES) != hipSuccess || per_cu < 1) { fprintf(stderr, "kernel_launch: occupancy query reports %d blocks per CU\n", per_cu); }
        (void)hipGetLastError();
        grid = cus;
    }
    if (grid < 0) return;
    if (hipMemsetAsync((char*)d_ws + WS_CTL, 0, CTL_ZERO_BYTES, stream) != hipSuccess) return;
    Args a{};
    for (int i = 0; i < 24; ++i) a.in[i] = (const float*)d_in[i];
    a.out = (float*)d_out; a.ws = (unsigned char*)d_ws;
#if MK_PER_PHASE
    for (int p = 0; p < NPH; ++p) { a.ph_lo = p; a.ph_hi = p + 1; hipLaunchKernelGGL(trunk_fwd, dim3(grid), dim3(NWAVES * 64), LDS_BYTES, stream, a); }
#else
    a.ph_lo = 0; a.ph_hi = NPH;
    hipLaunchKernelGGL(trunk_fwd, dim3(grid), dim3(NWAVES * 64), LDS_BYTES, stream, a);
#endif
    const hipError_t le = hipPeekAtLastError();
    if (le != hipSuccess) fprintf(stderr, "kernel_launch: launch failed: %s\n", hipGetErrorName(le));
}
```

```cpp
#include <hip/hip_runtime.h>
#include <cstdio>
#include <cstdint>

#ifndef MK_PER_PHASE
#define MK_PER_PHASE 0
#endif
#ifndef NAIVE_ATTN
#define NAIVE_ATTN 0
#endif

#ifndef PROBE_A
#define PROBE_A -1
#endif
#ifndef PROBE_B
#define PROBE_B -1
#endif
#ifndef PROBE_C
#define PROBE_C -1
#endif
#define GAS __attribute__((address_space(1)))
#define LAS __attribute__((address_space(3)))

namespace pg8 {
#define PG8_LAS __attribute__((address_space(3)))
typedef unsigned short bf16_t;
typedef short bf16x8 __attribute__((ext_vector_type(8)));
typedef float f32x4 __attribute__((ext_vector_type(4)));
typedef float f32x2 __attribute__((ext_vector_type(2)));
typedef unsigned u32x4 __attribute__((ext_vector_type(4)));
constexpr int BM = 256, BK = 64, HALF = 128, HTB = HALF * BK * 2  , STAGE_BYTES = 8 * HTB, NXCD = 8, WGM = 8;

__host__ __device__ __forceinline__ int lds_byte(int r, int c) { const int st = (r >> 4) * 2 + (c >> 5), rr = r & 15, cc = c & 31, ob = rr * 64 + cc * 2; return st * 1024 + (ob ^ (((ob >> 9) & 1) << 5)); }
__host__ __device__ __forceinline__ void stage_rc(int b, int& R, int& C) { const int st = b / 1024, sb = b % 1024, swz = sb ^ (((sb >> 9) & 1) << 5); R = (st >> 1) * 16 + swz / 64; C = (st & 1) * 32 + (swz % 64) / 2; }
__host__ __device__ __forceinline__ int perm32(int rho) { const int n = rho >> 4, i = rho & 15; return 8 * (i >> 2) + 4 * n + (i & 3); }

struct Unit { int pm, pn; long bo; int so; long ao, oo; };
typedef int i32x4 __attribute__((ext_vector_type(4)));
template <bool I8> struct AccSel { typedef f32x4 type; };
template <> struct AccSel<true> { typedef i32x4 type; };
template <class T> struct IsI8 { static constexpr bool v = false; };
template <> struct IsI8<i32x4> { static constexpr bool v = true; };
__device__ __forceinline__ void mma16(f32x4& c, bf16x8 b, bf16x8 a) { c = __builtin_amdgcn_mfma_f32_16x16x32_bf16(b, a, c, 0, 0, 0); }
__device__ __forceinline__ void mma16(i32x4& c, bf16x8 b, bf16x8 a) { c = __builtin_amdgcn_mfma_i32_16x16x64_i8(__builtin_bit_cast(i32x4, b), __builtin_bit_cast(i32x4, a), c, 0, 0, 0); }
__device__ __forceinline__ f32x4 accval(const f32x4& a, float, const f32x4&) { return a; }
__device__ __forceinline__ f32x4 accval(const i32x4& a, float sa, const f32x4& sb) { return __builtin_convertvector(a, f32x4) * (sb * sa); }
struct Gemm { const bf16_t* A; const bf16_t* Bt; int M, N, K, ld; };

struct StaticOrder {
    int nM, nN, nwg, G, c;
    __device__ void init(int M, int N, int G_, int c_) { nM = M / BM; nN = N / BM; nwg = nM * nN; G = G_; c = c_; }
    __device__ bool next(int i, Unit& u) const {
        const long L = (long)i * G + c; if (L >= nwg) return false;
        int wgid = (int)L; { const int q = nwg / NXCD, r = nwg % NXCD, xcd = wgid % NXCD, off = wgid / NXCD; wgid = (xcd < r ? xcd * (q + 1) : r * (q + 1) + (xcd - r) * q) + off; }
        const int nig = WGM * nN, gid = wgid / nig, fm = gid * WGM, gsz = (nM - fm) < WGM ? (nM - fm) : WGM;
        u.pm = fm + ((wgid % nig) % gsz); u.pn = (wgid % nig) / gsz; u.bo = 0; u.so = 0; u.ao = 0; u.oo = 0; return true;
    }
    __device__ __forceinline__ void a_ready(const Unit&) const {}
    __device__ __forceinline__ void done(const Unit&) const {}
};
struct GroupedOrder {
    int nM, nN, nwg, G, c; int tp1, tp2, tp3, tp4, tp5, tp6, tp7; long estride; int sstride;
    __device__ bool next(int i, Unit& u) const {
        const long L = (long)i * G + c; if (L >= nwg) return false;
        int wgid = (int)L; { const int q = nwg / NXCD, r = nwg % NXCD, xcd = wgid % NXCD, off = wgid / NXCD; wgid = (xcd < r ? xcd * (q + 1) : r * (q + 1) + (xcd - r) * q) + off; }
        const int nig = WGM * nN, gid = wgid / nig, fm = gid * WGM, gsz = (nM - fm) < WGM ? (nM - fm) : WGM;
        u.pm = fm + ((wgid % nig) % gsz); u.pn = (wgid % nig) / gsz;
        const int e = (u.pm >= tp1) + (u.pm >= tp2) + (u.pm >= tp3) + (u.pm >= tp4) + (u.pm >= tp5) + (u.pm >= tp6) + (u.pm >= tp7);
        u.bo = (long)e * estride; u.so = e * sstride; u.ao = 0; u.oo = 0; return true;
    }
    __device__ __forceinline__ void a_ready(const Unit&) const {}
    __device__ __forceinline__ void done(const Unit&) const {}
};

struct SplitKOrder {
    int nrem, G, c; int tp1, tp2, tp3, tp4, tp5, tp6, tp7; long estride; long pstride;
    __device__ bool next(int i, Unit& u) const {
        const long L = (long)i * G + c; if (L >= (long)nrem * 28) return false;
        const int p = (int)L % 7, un = (int)L / 7; u.pn = un & 3; u.pm = 256 + (un >> 2);
        const int e = (u.pm >= tp1) + (u.pm >= tp2) + (u.pm >= tp3) + (u.pm >= tp4) + (u.pm >= tp5) + (u.pm >= tp6) + (u.pm >= tp7);
        u.bo = (long)e * estride + (long)p * 1024; u.ao = (long)p * 1024; u.so = 0; u.oo = (long)p * pstride - (long)65536 * 1024; return true;
    }
    __device__ __forceinline__ void a_ready(const Unit&) const {}
    __device__ __forceinline__ void done(const Unit&) const {}
};

__device__ __forceinline__ unsigned cvt_pk_bf16(float lo, float hi) { unsigned r; asm volatile("v_cvt_pk_bf16_f32 %0, %1, %2" : "=v"(r) : "v"(lo), "v"(hi)); return r; }

struct EpiBf16S {
    static constexpr bool PERM = true, AFTER_DRAIN = false;
    bf16_t* O; int ldc; const float* bias; int nsc; float sc; const float* sA; const float* sB;
    template <class AccT>
    __device__ __forceinline__ void operator()(const AccT (&acc)[2][2][4][2], const Unit& u, int wr, int wc, int fr, int fq) const {
        constexpr bool I8 = IsI8<AccT>::v;
        const int row0 = u.pm * BM + wr * 64 + fr, col0 = u.pn * BM + wc * 32 + 8 * fq;
        const float s = (u.pn < nsc) ? sc : 1.f;
        f32x4 bv[2][2], sb[2][2];
#pragma unroll
        for (int bj = 0; bj < 2; ++bj)
#pragma unroll
            for (int n = 0; n < 2; ++n) sb[bj][n] = I8 ? *(const f32x4*)(sB + u.so + col0 + bj * HALF + 4 * n) : (f32x4){1.f, 1.f, 1.f, 1.f};
#pragma unroll
        for (int bj = 0; bj < 2; ++bj)
#pragma unroll
            for (int n = 0; n < 2; ++n) bv[bj][n] = bias ? *(const f32x4*)(bias + col0 + bj * HALF + 4 * n) : (f32x4){0.f, 0.f, 0.f, 0.f};
        float sav[2][4];
#pragma unroll
        for (int ai = 0; ai < 2; ++ai)
#pragma unroll
            for (int m = 0; m < 4; ++m) sav[ai][m] = I8 ? sA[row0 + ai * HALF + m * 16] : 1.f;
        asm volatile("" : "+v"(sav[0][0]), "+v"(sav[0][1]), "+v"(sav[0][2]), "+v"(sav[0][3]), "+v"(sav[1][0]), "+v"(sav[1][1]), "+v"(sav[1][2]), "+v"(sav[1][3]));
#pragma unroll
        for (int ai = 0; ai < 2; ++ai)
#pragma unroll
            for (int m = 0; m < 4; ++m) { bf16_t* rowp = O + u.oo + (size_t)(row0 + ai * HALF + m * 16) * ldc + col0;
                const float sa = sav[ai][m];
#pragma unroll
                for (int bj = 0; bj < 2; ++bj) { f32x4 v0 = (accval(acc[ai][bj][m][0], sa, sb[bj][0]) + bv[bj][0]) * s, v1 = (accval(acc[ai][bj][m][1], sa, sb[bj][1]) + bv[bj][1]) * s;
                    u32x4 w; w.x = cvt_pk_bf16(v0[0], v0[1]); w.y = cvt_pk_bf16(v0[2], v0[3]); w.z = cvt_pk_bf16(v1[0], v1[1]); w.w = cvt_pk_bf16(v1[2], v1[3]);
                    *(u32x4*)(rowp + bj * HALF) = w; } }
    }
};
__device__ __forceinline__ float silu_mul(float g, float u) { return g * u * __builtin_amdgcn_rcpf(1.f + __builtin_amdgcn_exp2f(-1.4426950408889634f * g)); }
struct EpiSwiGLU {
    static constexpr bool PERM = true, AFTER_DRAIN = false;
    bf16_t* O; int ldc; const float* sA; const float* sB;
    template <class AccT>
    __device__ __forceinline__ void operator()(const AccT (&acc)[2][2][4][2], const Unit& u, int wr, int wc, int fr, int fq) const {
        constexpr bool I8 = IsI8<AccT>::v;
        const int row0 = u.pm * BM + wr * 64 + fr, col0 = u.pn * HALF + wc * 32 + 8 * fq, colb = u.pn * BM + wc * 32 + 8 * fq;
        f32x4 sb[2][2];
#pragma unroll
        for (int bj = 0; bj < 2; ++bj)
#pragma unroll
            for (int n = 0; n < 2; ++n) sb[bj][n] = I8 ? *(const f32x4*)(sB + u.so + colb + bj * HALF + 4 * n) : (f32x4){1.f, 1.f, 1.f, 1.f};
        float sav[2][4];
#pragma unroll
        for (int ai = 0; ai < 2; ++ai)
#pragma unroll
            for (int m = 0; m < 4; ++m) sav[ai][m] = I8 ? sA[row0 + ai * HALF + m * 16] : 1.f;
        asm volatile("" : "+v"(sav[0][0]), "+v"(sav[0][1]), "+v"(sav[0][2]), "+v"(sav[0][3]), "+v"(sav[1][0]), "+v"(sav[1][1]), "+v"(sav[1][2]), "+v"(sav[1][3]));
#pragma unroll
        for (int ai = 0; ai < 2; ++ai)
#pragma unroll
            for (int m = 0; m < 4; ++m) { bf16_t* rowp = O + u.oo + (size_t)(row0 + ai * HALF + m * 16) * ldc + col0;
                const float sa = sav[ai][m];
                const f32x4 g0 = accval(acc[ai][0][m][0], sa, sb[0][0]), g1 = accval(acc[ai][0][m][1], sa, sb[0][1]), u0 = accval(acc[ai][1][m][0], sa, sb[1][0]), u1 = accval(acc[ai][1][m][1], sa, sb[1][1]);
                u32x4 w; w.x = cvt_pk_bf16(silu_mul(g0[0], u0[0]), silu_mul(g0[1], u0[1])); w.y = cvt_pk_bf16(silu_mul(g0[2], u0[2]), silu_mul(g0[3], u0[3]));
                w.z = cvt_pk_bf16(silu_mul(g1[0], u1[0]), silu_mul(g1[1], u1[1])); w.w = cvt_pk_bf16(silu_mul(g1[2], u1[2]), silu_mul(g1[3], u1[3]));
                *(u32x4*)rowp = w; }
    }
};
struct EpiResF32 {
    static constexpr bool PERM = false, AFTER_DRAIN = false;
    const float* base; float* out; int ldc;
    __device__ __forceinline__ void operator()(const f32x4 (&acc)[2][2][4][2], const Unit& u, int wr, int wc, int fr, int fq) const {
        const int row0 = u.pm * BM + wr * 64 + fr, col0 = u.pn * BM + wc * 32 + 4 * fq;
#pragma unroll
        for (int ai = 0; ai < 2; ++ai) {
            f32x4 bs[4][2][2];
#pragma unroll
            for (int m = 0; m < 4; ++m) { const size_t off = (size_t)(row0 + ai * HALF + m * 16) * ldc + col0;
#pragma unroll
                for (int bj = 0; bj < 2; ++bj)
#pragma unroll
                    for (int n = 0; n < 2; ++n) bs[m][bj][n] = *(const f32x4*)(base + off + bj * HALF + n * 16); }
#pragma unroll
            for (int m = 0; m < 4; ++m)
#pragma unroll
                for (int bj = 0; bj < 2; ++bj)
#pragma unroll
                    for (int n = 0; n < 2; ++n) asm volatile("" : "+v"(bs[m][bj][n]));
#pragma unroll
            for (int m = 0; m < 4; ++m) { const size_t off = (size_t)(row0 + ai * HALF + m * 16) * ldc + col0;
#pragma unroll
                for (int bj = 0; bj < 2; ++bj)
#pragma unroll
                    for (int n = 0; n < 2; ++n) *(f32x4*)(out + off + bj * HALF + n * 16) = bs[m][bj][n] + acc[ai][bj][m][n]; } }
    }
};

template <class Epi, class Sched, bool ALIGN_EPI = false, bool SP2 = false, bool I8 = false>
__device__ __forceinline__ void gemm_phase(PG8_LAS unsigned char* lds, const Gemm g, const Sched& S, const Epi& E) {
    const int tid = threadIdx.x, wid = __builtin_amdgcn_readfirstlane(tid >> 6), lane = tid & 63, wr = wid >> 2, wc = wid & 3, fr = lane & 15, fq = lane >> 4;
    constexpr int ES = I8 ? 1 : 2;
    typedef typename AccSel<I8>::type acc_t;
    const int K = g.K, nt = K * ES / (BK * 2);
    unsigned voffA[2], voffB[2];
#pragma unroll
    for (int i = 0; i < 2; ++i) { int R, C; stage_rc(tid * 16 + i * 8192, R, C); const int Rb = Epi::PERM ? ((R & ~31) + perm32(R & 31)) : R;
        voffA[i] = (unsigned)(R * g.ld * ES + C * 2); voffB[i] = (unsigned)(Rb * g.ld * ES + C * 2); }
    const size_t kstep = (size_t)(BK * 2);
    const size_t hstep = (size_t)HALF * g.ld * ES;
    const size_t tstep = 2 * hstep;
    const unsigned ldsw = (unsigned)wid * 1024u;
    const int aoff = lds_byte(wr * 64 + fr, fq * 8), boff = lds_byte(wc * 32 + fr, fq * 8);
#define PG8_SA(b, h) (((b) * 2 + (h)) * HTB)
#define PG8_SB(b, h) ((4 + (b) * 2 + (h)) * HTB)
#define PG8_STAGE(bufoff, gbase, voff) do { _Pragma("unroll") for (int _i = 0; _i < 2; ++_i) \
        __builtin_amdgcn_global_load_lds((const unsigned*)((const char*)(gbase) + (voff)[_i]), (PG8_LAS unsigned*)(lds + (bufoff) + ldsw + _i * 8192), 16, 0, 0); } while (0)
#define PG8_LDA(dst, b, h) do { _Pragma("unroll") for (int m = 0; m < 4; ++m) _Pragma("unroll") for (int k = 0; k < 2; ++k) dst[m][k] = *(const PG8_LAS bf16x8*)(lds + PG8_SA(b, h) + aoff + m * 2048 + k * 1024); } while (0)
#define PG8_LDB(dst, b, h) do { _Pragma("unroll") for (int n = 0; n < 2; ++n) _Pragma("unroll") for (int k = 0; k < 2; ++k) dst[n][k] = *(const PG8_LAS bf16x8*)(lds + PG8_SB(b, h) + boff + n * 2048 + k * 1024); } while (0)
#define PG8_MMA(ai, bj, At, Bt) do { __builtin_amdgcn_s_setprio(1); _Pragma("unroll") for (int m = 0; m < 4; ++m) _Pragma("unroll") for (int n = 0; n < 2; ++n) _Pragma("unroll") for (int k = 0; k < 2; ++k) \
        mma16(acc[ai][bj][m][n], Bt[n][k], At[m][k]); __builtin_amdgcn_s_setprio(0); } while (0)
#define PG8_WAIT_V(n) asm volatile("s_waitcnt vmcnt(" #n ")" ::: "memory")
#define PG8_WAIT_L(n) asm volatile("s_waitcnt lgkmcnt(" #n ")" ::: "memory")
#define PG8_BAR __builtin_amdgcn_s_barrier()
#define PG8_SCHED __builtin_amdgcn_sched_barrier(0)
    Unit cur, nxt; int ui = 0;
    if (!S.next(0, cur)) return;
    acc_t acc[2][2][4][2];
#pragma unroll
    for (int a = 0; a < 2; ++a)
#pragma unroll
        for (int b = 0; b < 2; ++b)
#pragma unroll
            for (int m = 0; m < 4; ++m)
#pragma unroll
                for (int n = 0; n < 2; ++n) acc[a][b][m][n] = acc_t{};
    bf16x8 At[4][2], B0[2][2], B1[2][2];
    const char* cA = (const char*)g.A + cur.ao + (size_t)cur.pm * tstep; const char* cB = (const char*)g.Bt + cur.bo + (size_t)cur.pn * tstep;
    S.a_ready(cur);
    if constexpr (SP2) {
        PG8_STAGE(PG8_SB(0, 0), cB, voffB); PG8_STAGE(PG8_SB(0, 1), cB + hstep, voffB); PG8_STAGE(PG8_SA(0, 0), cA, voffA); PG8_STAGE(PG8_SA(0, 1), cA + hstep, voffA);
        if (wr == 1) PG8_BAR;
        PG8_WAIT_V(2); PG8_BAR;
        PG8_STAGE(PG8_SB(1, 0), cB + kstep, voffB); PG8_STAGE(PG8_SA(1, 0), cA + kstep, voffA); PG8_STAGE(PG8_SB(1, 1), cB + hstep + kstep, voffB);
        PG8_WAIT_V(6); PG8_BAR;
    } else {
        PG8_STAGE(PG8_SB(0, 0), cB, voffB); PG8_STAGE(PG8_SA(0, 0), cA, voffA); PG8_STAGE(PG8_SB(0, 1), cB + hstep, voffB); PG8_STAGE(PG8_SA(0, 1), cA + hstep, voffA);
        if (wr == 1) PG8_BAR;
        PG8_WAIT_V(4); PG8_BAR;
        PG8_STAGE(PG8_SB(1, 0), cB + kstep, voffB); PG8_STAGE(PG8_SA(1, 0), cA + kstep, voffA); PG8_STAGE(PG8_SB(1, 1), cB + hstep + kstep, voffB);
        PG8_WAIT_V(6); PG8_BAR;
    }
    for (;;) {
        const bool has_next = S.next(ui + 1, nxt);
        const char* nA = has_next ? (const char*)g.A + nxt.ao + (size_t)nxt.pm * tstep : cA; const char* nB = has_next ? (const char*)g.Bt + nxt.bo + (size_t)nxt.pn * tstep : cB;
        for (int t = 0; t < nt; t += 2) {
            const bool last = (t == nt - 2);
            const char* a1 = cA + (size_t)(t + 1) * kstep;
            const char* a2 = last ? nA : cA + (size_t)(t + 2) * kstep; const char* b2 = last ? nB : cB + (size_t)(t + 2) * kstep;
            const char* a3 = a2 + kstep; const char* b3 = b2 + kstep;
            if (last && has_next) S.a_ready(nxt);
            if constexpr (SP2) {
            PG8_LDB(B0, 0, 0); PG8_LDB(B1, 0, 1); PG8_SCHED; PG8_LDA(At, 0, 0); PG8_STAGE(PG8_SA(1, 1), a1 + hstep, voffA);
            PG8_WAIT_V(8); PG8_WAIT_L(0); PG8_BAR; PG8_MMA(0, 0, At, B0); PG8_MMA(0, 1, At, B1); PG8_BAR; PG8_SCHED;
            PG8_LDA(At, 0, 1); PG8_STAGE(PG8_SB(0, 0), b2, voffB); PG8_STAGE(PG8_SB(0, 1), b2 + hstep, voffB); PG8_STAGE(PG8_SA(0, 0), a2, voffA);
            PG8_WAIT_V(8); PG8_WAIT_L(0); PG8_BAR; PG8_MMA(1, 0, At, B0); PG8_MMA(1, 1, At, B1); PG8_BAR; PG8_SCHED;
            PG8_LDB(B0, 1, 0); PG8_LDB(B1, 1, 1); PG8_SCHED; PG8_LDA(At, 1, 0); PG8_STAGE(PG8_SA(0, 1), a2 + hstep, voffA);
            PG8_WAIT_V(8); PG8_WAIT_L(0); PG8_BAR; PG8_MMA(0, 0, At, B0); PG8_MMA(0, 1, At, B1); PG8_BAR; PG8_SCHED;
            PG8_LDA(At, 1, 1); PG8_STAGE(PG8_SB(1, 0), b3, voffB); PG8_STAGE(PG8_SB(1, 1), b3 + hstep, voffB); PG8_STAGE(PG8_SA(1, 0), a3, voffA);
            PG8_WAIT_V(8); PG8_WAIT_L(0); PG8_BAR; PG8_MMA(1, 0, At, B0); PG8_MMA(1, 1, At, B1); PG8_BAR; PG8_SCHED;
            } else {
            PG8_LDB(B0, 0, 0); PG8_SCHED; PG8_LDA(At, 0, 0); PG8_STAGE(PG8_SA(1, 1), a1 + hstep, voffA);
            PG8_WAIT_L(8); PG8_BAR; PG8_WAIT_L(0); PG8_MMA(0, 0, At, B0); PG8_BAR; PG8_SCHED;
            PG8_LDB(B1, 0, 1); PG8_STAGE(PG8_SB(0, 0), b2, voffB);
            PG8_BAR; PG8_WAIT_L(0); PG8_MMA(0, 1, At, B1); PG8_BAR;
            PG8_LDA(At, 0, 1); PG8_STAGE(PG8_SA(0, 0), a2, voffA);
            PG8_BAR; PG8_WAIT_L(0); PG8_MMA(1, 0, At, B0); PG8_BAR; PG8_SCHED;
            PG8_STAGE(PG8_SB(0, 1), b2 + hstep, voffB);
            PG8_WAIT_V(6); PG8_BAR; PG8_MMA(1, 1, At, B1); PG8_BAR;
            PG8_LDB(B0, 1, 0); PG8_SCHED; PG8_LDA(At, 1, 0); PG8_STAGE(PG8_SA(0, 1), a2 + hstep, voffA);
            PG8_WAIT_L(8); PG8_BAR; PG8_WAIT_L(0); PG8_MMA(0, 0, At, B0); PG8_BAR; PG8_SCHED;
            PG8_LDB(B1, 1, 1); PG8_STAGE(PG8_SB(1, 0), b3, voffB);
            PG8_BAR; PG8_WAIT_L(0); PG8_MMA(0, 1, At, B1); PG8_BAR;
            PG8_LDA(At, 1, 1); PG8_STAGE(PG8_SA(1, 0), a3, voffA);
            PG8_BAR; PG8_WAIT_L(0); PG8_MMA(1, 0, At, B0); PG8_BAR; PG8_SCHED;
            PG8_STAGE(PG8_SB(1, 1), b3 + hstep, voffB);
            PG8_WAIT_V(6); PG8_BAR; PG8_MMA(1, 1, At, B1); PG8_BAR;
            }
        }
        if constexpr (ALIGN_EPI) { if (wr == 0) PG8_BAR; }
        if constexpr (!Epi::AFTER_DRAIN) { E(acc, cur, wr, wc, fr, fq); S.done(cur); }
        if (!has_next) break;
#pragma unroll
        for (int a = 0; a < 2; ++a)
#pragma unroll
            for (int b = 0; b < 2; ++b)
#pragma unroll
                for (int m = 0; m < 4; ++m)
#pragma unroll
                    for (int n = 0; n < 2; ++n) acc[a][b][m][n] = acc_t{};
        cur = nxt; cA = nA; cB = nB; ++ui;
        if constexpr (ALIGN_EPI) { if (wr == 1) PG8_BAR; }
    }
    PG8_WAIT_V(0);
    if constexpr (!ALIGN_EPI) { if (wr == 0) PG8_BAR; }
    PG8_BAR;
    if constexpr (Epi::AFTER_DRAIN) { E.fused(acc, cur, wr, wc, fr, fq, lds, wid, lane); S.done(cur); }
#undef PG8_SA
#undef PG8_SB
#undef PG8_STAGE
#undef PG8_LDA
#undef PG8_LDB
#undef PG8_MMA
#undef PG8_WAIT_V
#undef PG8_WAIT_L
#undef PG8_BAR
#undef PG8_SCHED
}
}

namespace att {
typedef unsigned short bf16;
typedef short bf16x8 __attribute__((ext_vector_type(8)));
typedef short s16x4 __attribute__((ext_vector_type(4)));
typedef float f32x16 __attribute__((ext_vector_type(16)));
typedef float f32x4 __attribute__((ext_vector_type(4)));
typedef unsigned u32x4 __attribute__((ext_vector_type(4)));
typedef float f32x2_t __attribute__((ext_vector_type(2))); typedef __bf16 bf16x2_t __attribute__((ext_vector_type(2)));
constexpr int SEQ = 4096;
constexpr float LOG2E = 1.4426950408889634f;
struct Args { const bf16* Q; int qpitch, qhs; const bf16* K; int kpitch, khs; const bf16* K2; const bf16* V; int vpitch, vhs; bf16* O; const float* cosT; const float* sinT; const float* relb; const float* sinks; };

__device__ __forceinline__ int crow(int r, int hi) { return (r & 3) + 8 * (r >> 2) + 4 * hi; }
__device__ __forceinline__ unsigned cvtpk(float lo, float hi) { f32x2_t v = {lo, hi}; bf16x2_t b = __builtin_convertvector(v, bf16x2_t); return __builtin_bit_cast(unsigned, b); }
__device__ __forceinline__ float bf2f(unsigned short h) { return __builtin_bit_cast(float, (unsigned)h << 16); }
__device__ __forceinline__ unsigned short f2bf(float f) { unsigned u = __builtin_bit_cast(unsigned, f); return (unsigned short)((u + 0x7fffu + ((u >> 16) & 1u)) >> 16); }
__device__ __forceinline__ float ex2(float x) { return __builtin_amdgcn_exp2f(x); }
__device__ __forceinline__ float lg2(float x) { return __builtin_amdgcn_logf(x); }
#define ATT_SBAR() __builtin_amdgcn_sched_barrier(0)
__device__ __forceinline__ void pv(f32x16* o, int vb, bf16x8 pa0, bf16x8 pa1, bf16x8 pa2, bf16x8 pa3) {
  s16x4 lo0[4], hi0[4], lo1[4], hi1[4];
#pragma unroll
  for (int ks = 0; ks < 4; ++ks) {
    asm volatile("ds_read_b64_tr_b16 %0,%1 offset:%c2" : "=&v"(lo0[ks]) : "v"(vb), "i"(ks * 1024) : "memory");
    asm volatile("ds_read_b64_tr_b16 %0,%1 offset:%c2" : "=&v"(hi0[ks]) : "v"(vb), "i"(ks * 1024 + 512) : "memory"); }
#pragma unroll
  for (int ks = 0; ks < 4; ++ks) {
    asm volatile("ds_read_b64_tr_b16 %0,%1 offset:%c2" : "=&v"(lo1[ks]) : "v"(vb), "i"(4096 + ks * 1024) : "memory");
    asm volatile("ds_read_b64_tr_b16 %0,%1 offset:%c2" : "=&v"(hi1[ks]) : "v"(vb), "i"(4096 + ks * 1024 + 512) : "memory"); }
  asm volatile("s_waitcnt lgkmcnt(8)" : "+v"(lo0[0]), "+v"(hi0[0]), "+v"(lo0[1]), "+v"(hi0[1]), "+v"(lo0[2]), "+v"(hi0[2]), "+v"(lo0[3]), "+v"(hi0[3]) :: "memory"); ATT_SBAR();
#define ATT_PK(lo, hi, k) (bf16x8){lo[k][0], lo[k][1], lo[k][2], lo[k][3], hi[k][0], hi[k][1], hi[k][2], hi[k][3]}
  o[0] = __builtin_amdgcn_mfma_f32_32x32x16_bf16(pa0, ATT_PK(lo0, hi0, 0), o[0], 0, 0, 0);
  o[0] = __builtin_amdgcn_mfma_f32_32x32x16_bf16(pa1, ATT_PK(lo0, hi0, 1), o[0], 0, 0, 0);
  o[0] = __builtin_amdgcn_mfma_f32_32x32x16_bf16(pa2, ATT_PK(lo0, hi0, 2), o[0], 0, 0, 0);
  o[0] = __builtin_amdgcn_mfma_f32_32x32x16_bf16(pa3, ATT_PK(lo0, hi0, 3), o[0], 0, 0, 0);
  asm volatile("s_waitcnt lgkmcnt(0)" : "+v"(lo1[0]), "+v"(hi1[0]), "+v"(lo1[1]), "+v"(hi1[1]), "+v"(lo1[2]), "+v"(hi1[2]), "+v"(lo1[3]), "+v"(hi1[3]) :: "memory"); ATT_SBAR();
  o[1] = __builtin_amdgcn_mfma_f32_32x32x16_bf16(pa0, ATT_PK(lo1, hi1, 0), o[1], 0, 0, 0);
  o[1] = __builtin_amdgcn_mfma_f32_32x32x16_bf16(pa1, ATT_PK(lo1, hi1, 1), o[1], 0, 0, 0);
  o[1] = __builtin_amdgcn_mfma_f32_32x32x16_bf16(pa2, ATT_PK(lo1, hi1, 2), o[1], 0, 0, 0);
  o[1] = __builtin_amdgcn_mfma_f32_32x32x16_bf16(pa3, ATT_PK(lo1, hi1, 3), o[1], 0, 0, 0);
#undef ATT_PK
}
__device__ __forceinline__ float max3f(float a, float b, float c) { float r; asm("v_max3_f32 %0, %1, %2, %3" : "=v"(r) : "v"(a), "v"(b), "v"(c)); return r; }
__device__ __forceinline__ float xmax(float v) { auto rr = __builtin_amdgcn_permlane32_swap(__float_as_uint(v), __float_as_uint(v), false, false); return fmaxf(__uint_as_float(rr[0]), __uint_as_float(rr[1])); }
__device__ __forceinline__ float xsum(float v) { auto rr = __builtin_amdgcn_permlane32_swap(__float_as_uint(v), __float_as_uint(v), false, false); return __uint_as_float(rr[0]) + __uint_as_float(rr[1]); }

__device__ __forceinline__ void softmax_tile(f32x16& p0, f32x16& p1, float& m, float& l, f32x16& negm, f32x16& o0, f32x16& o1, f32x16& q0, f32x16& q1, LAS float* wsf, int r32, int hi) {
  constexpr float THR = 8.f;
  float a = max3f(p0[0], p0[1], p1[0]), b = max3f(p0[2], p0[3], p1[1]); a = max3f(a, p1[2], p1[3]);
#pragma unroll
  for (int r = 4; r < 16; r += 4) { a = max3f(a, p0[r], p0[r + 1]); b = max3f(b, p0[r + 2], p0[r + 3]); a = max3f(a, p1[r], p1[r + 1]); b = max3f(b, p1[r + 2], p1[r + 3]); }
  const float rm = xmax(max3f(a, b, b));
  if (__any(rm > THR || (l == 0.f && rm < -40.f && rm > -1e29f))) {
    const float dl = (rm > 0.f || (l == 0.f && rm < -40.f && rm > -1e29f)) ? rm : 0.f;
    m += dl;
#pragma unroll
    for (int r = 0; r < 16; ++r) { negm[r] = -m; p0[r] -= dl; p1[r] -= dl; q0[r] -= dl; q1[r] -= dl; }
    const float f = ex2(-dl); l *= f;
    if (hi == 0) wsf[r32] = f;
#pragma unroll
    for (int r = 0; r < 16; ++r) { const float fr = wsf[crow(r, hi)]; o0[r] *= fr; o1[r] *= fr; }
  }
  float rs = 0.f;
#pragma unroll
  for (int r = 0; r < 16; ++r) { p0[r] = ex2(p0[r]); p1[r] = ex2(p1[r]); rs += p0[r] + p1[r]; }
  l += xsum(rs);
}

template <int MODE> struct Lay {
  static constexpr int DKC = (MODE == 2) ? 12 : 8, ND0 = DKC / 2, KSLOT = DKC * 1024, VSLOT = 8192;
  static constexpr int NSL = 4;
  static constexpr int OFF_K = 0, OFF_V = NSL * KSLOT, OFF_WS = OFF_V + NSL * VSLOT, OFF_BT = OFF_WS + 8 * 256, OFF_FL = OFF_BT + 8 * 512, OFF_OST = OFF_FL + 256, TOTAL = OFF_OST + 8 * 4096;
};

template <int MODE>
__device__ __forceinline__ void attn_unit(LAS char* shm, const Args& A, int b, int hsel, int qblk, bool rebuild) {
  typedef Lay<MODE> L;
  constexpr int ND0 = L::ND0, KSLOT = L::KSLOT, VSLOT = L::VSLOT;
  constexpr float NEG = -1e30f;
  const int tid = threadIdx.x, lane = tid & 63, r32 = lane & 31, hi = lane >> 5;
  const int wid = __builtin_amdgcn_readfirstlane(tid >> 6);
  const long rowbase = (long)b * SEQ;
  const int qrow0 = (MODE == 0) ? 32 * qblk : 256 * qblk + 32 * wid;
  const int head = (MODE == 0) ? hsel * 8 + wid : hsel;
  int tlo, thi;
  if (MODE == 0) { tlo = qrow0 >= 127 ? (qrow0 - 127) >> 6 : 0; thi = (qrow0 + 31) >> 6; } else { tlo = 0; thi = 4 * qblk + 3; }
  const int wmax = (MODE == 1) ? (qrow0 + 30) >> 6 : (qrow0 + 31) >> 6;
  const int n = thi - tlo + 1;
  LAS float* wsf = (LAS float*)(shm + L::OFF_WS) + wid * 64;
  LAS float* btab = (LAS float*)(shm + L::OFF_BT) + wid * 128;
  LAS unsigned* fl = (LAS unsigned*)(shm + L::OFF_FL);
  const int q = qrow0 + r32;
  const bf16* Qw = A.Q + (rowbase + q) * (long)A.qpitch + head * A.qhs + hi * 8;
  bf16x8 qr[ND0];
#pragma unroll
  for (int d0 = 0; d0 < ND0; ++d0) qr[d0] = *(const bf16x8*)(Qw + d0 * 16);
  f32x4 rc0 = {0.f, 0.f, 0.f, 0.f}, rc1 = rc0, rs0 = rc0, rs1 = rc0; float sink_ = 0.f;
  if (MODE == 2) { const f32x4* cp_ = (const f32x4*)(A.cosT + q * 16 + hi * 8); const f32x4* sp_ = (const f32x4*)(A.sinT + q * 16 + hi * 8); rc0 = cp_[0]; rc1 = cp_[1]; rs0 = sp_[0]; rs1 = sp_[1]; }
  if (MODE == 0) sink_ = A.sinks[head];
  f32x16 o[2]; o[0] = f32x16{}; o[1] = f32x16{};
  const bf16* ksrc = A.K + (rowbase + lane) * (long)A.kpitch + hsel * A.khs + wid * 8;
  const bf16* k2src = (MODE == 2) ? A.K2 + (rowbase + lane) * 32 + (wid & 3) * 8 : nullptr;
  const bf16* vsrc = A.V + (rowbase + 16 * (wid & 3) + (lane >> 2)) * (long)A.vpitch + hsel * A.vhs + (wid >> 2) * 32 + (lane & 3) * 8;
  const int vb0 = (int)(unsigned)(uintptr_t)(shm + L::OFF_V) + ((lane >> 4) & 1) * 32 + (lane & 3) * 8 + (4 * hi + ((lane & 15) >> 2)) * 64;
  u32x4 kreg, k2reg = (u32x4){0u, 0u, 0u, 0u}, vreg;
  u32x4 kB = (u32x4){0u, 0u, 0u, 0u}, vB = kB, kC = kB, vC = kB;
#define ATT_TILE(i_) ((MODE == 1) ? thi - (i_) : tlo + (i_))
#define ATT_LOAD(t_) do { kreg = *(const u32x4*)(ksrc + (long)(t_) * 64 * A.kpitch); vreg = *(const u32x4*)(vsrc + (long)(t_) * 64 * A.vpitch); \
    if (MODE == 2 && wid < 4) k2reg = *(const u32x4*)(k2src + (long)(t_) * 64 * 32); } while (0)
#define ATT_STAGE(sl_) do { *(LAS u32x4*)(shm + L::OFF_K + (sl_) * KSLOT + wid * 1024 + lane * 16) = kreg; \
    if (MODE == 2 && wid < 4) *(LAS u32x4*)(shm + L::OFF_K + (sl_) * KSLOT + (8 + wid) * 1024 + lane * 16) = k2reg; \
    *(LAS u32x4*)(shm + L::OFF_V + (sl_) * VSLOT + wid * 1024 + lane * 16) = vreg; } while (0)
#define ATT_QK(P0, P1, sl_) do { LAS const char* kb_ = shm + L::OFF_K + (sl_) * KSLOT + hi * 1024 + r32 * 16; bf16x8 kf_[2 * ND0]; \
    _Pragma("unroll") for (int d0 = 0; d0 < ND0; ++d0) { kf_[2 * d0] = *(LAS const bf16x8*)(kb_ + d0 * 2048); kf_[2 * d0 + 1] = *(LAS const bf16x8*)(kb_ + d0 * 2048 + 512); } \
    P0 = __builtin_amdgcn_mfma_f32_32x32x16_bf16(kf_[0], qr[0], negm, 0, 0, 0); P1 = __builtin_amdgcn_mfma_f32_32x32x16_bf16(kf_[1], qr[0], negm, 0, 0, 0); \
    _Pragma("unroll") for (int d0 = 1; d0 < ND0; ++d0) { P0 = __builtin_amdgcn_mfma_f32_32x32x16_bf16(kf_[2 * d0], qr[d0], P0, 0, 0, 0); P1 = __builtin_amdgcn_mfma_f32_32x32x16_bf16(kf_[2 * d0 + 1], qr[d0], P1, 0, 0, 0); } } while (0)
  ATT_LOAD(ATT_TILE(0));
  if (MODE == 0) { if (n > 1) { kB = *(const u32x4*)(ksrc + (long)ATT_TILE(1) * 64 * A.kpitch); vB = *(const u32x4*)(vsrc + (long)ATT_TILE(1) * 64 * A.vpitch); }
                   if (n > 2) { kC = *(const u32x4*)(ksrc + (long)ATT_TILE(2) * 64 * A.kpitch); vC = *(const u32x4*)(vsrc + (long)ATT_TILE(2) * 64 * A.vpitch); } }
  ATT_STAGE(0);
  if (MODE != 0 && n > 1) ATT_LOAD(ATT_TILE(1));
  if (MODE == 2) {
#pragma unroll
    for (int j = 0; j < 8; ++j) { const float c = j < 4 ? rc0[j & 3] : rc1[j & 3], sn_ = j < 4 ? rs0[j & 3] : rs1[j & 3];
      const float x1 = bf2f((unsigned short)qr[ND0 - 2][j]), x2 = bf2f((unsigned short)qr[ND0 - 1][j]);
      qr[ND0 - 2][j] = (short)f2bf(x1 * c - x2 * sn_); qr[ND0 - 1][j] = (short)f2bf(x1 * sn_ + x2 * c); }
  }
  float m = 0.f, l = 0.f, cp = 1.f; bool wdone = false;
  if (MODE == 0) {
    if (rebuild) {
      int bk0 = lane, bk1 = 16 + (int)(__logf((float)(lane + 64) * (1.f / 16.f)) * (16.f / 2.0794415416798357f)); bk1 = bk1 > 31 ? 31 : bk1;
      if (lane >= 16) { bk0 = 16 + (int)(__logf((float)lane * (1.f / 16.f)) * (16.f / 2.0794415416798357f)); bk0 = bk0 > 31 ? 31 : bk0; }
      const float t0 = A.relb[bk0 * 16 + head], t1 = A.relb[bk1 * 16 + head];
      btab[lane] = t0 * LOG2E; btab[lane + 64] = t1 * LOG2E; }
    m = sink_ * LOG2E; l = 1.f;
  }
  f32x16 negm;
#pragma unroll
  for (int r = 0; r < 16; ++r) negm[r] = (MODE == 1) ? 0.f : -m;
  __syncthreads();
  f32x16 p0 = f32x16{}, p1 = f32x16{}, q0 = f32x16{}, q1 = f32x16{};
  if (ATT_TILE(0) <= wmax) ATT_QK(p0, p1, 0);
  int sl = 0, sln = 1;
  bool have_pv = false; int pv_sl = 0; u32x4 pw0 = (u32x4){0u, 0u, 0u, 0u}, pw1 = pw0, pw2 = pw0, pw3 = pw0;
  for (int i = 0; i < n; ++i) {
    const int t = ATT_TILE(i);
    if (MODE == 0) { if (i == 0) { kreg = kB; vreg = vB; } else { kreg = kC; vreg = vC; } }
    if (i + 1 < n) ATT_STAGE(sln);
    __syncthreads();
    if (MODE == 1 && i >= 1) { const int fb = (i & 1) * 8; unsigned a = fl[fb + 0] & fl[fb + 1] & fl[fb + 2] & fl[fb + 3] & fl[fb + 4] & fl[fb + 5] & fl[fb + 6] & fl[fb + 7];
      if (__builtin_amdgcn_readfirstlane(a)) break; }
    if (MODE != 0 && i + 2 < n) ATT_LOAD(ATT_TILE(i + 2));
    if (i + 1 < n && ATT_TILE(i + 1) <= wmax && !(MODE == 1 && wdone)) ATT_QK(q0, q1, sln);
    if (have_pv) { pv(o, vb0 + pv_sl * VSLOT, __builtin_bit_cast(bf16x8, pw0), __builtin_bit_cast(bf16x8, pw1), __builtin_bit_cast(bf16x8, pw2), __builtin_bit_cast(bf16x8, pw3)); have_pv = false; }
    ATT_SBAR();
    if (t <= wmax && !(MODE == 1 && wdone)) {
      const int kt0 = t * 64;
      if (MODE == 2) {
        if (kt0 + 63 > qrow0) {
#pragma unroll
          for (int r = 0; r < 16; ++r) { const int key = kt0 + crow(r, hi); if (key > q) p0[r] = NEG; if (key + 32 > q) p1[r] = NEG; }
        }
        softmax_tile(p0, p1, m, l, negm, o[0], o[1], q0, q1, wsf, r32, hi);
      } else if (MODE == 0) {
#pragma unroll
        for (int r = 0; r < 16; r += 4) {
          float bb0[4], bb1[4];
#pragma unroll
          for (int k = 0; k < 4; ++k) { const int d0_ = q - (kt0 + crow(r + k, hi)); bb0[k] = btab[d0_ & 127]; bb1[k] = btab[(d0_ - 32) & 127]; }
          asm volatile("" : "+v"(bb0[0]), "+v"(bb0[1]), "+v"(bb0[2]), "+v"(bb0[3]), "+v"(bb1[0]), "+v"(bb1[1]), "+v"(bb1[2]), "+v"(bb1[3]));
#pragma unroll
          for (int k = 0; k < 4; ++k) { const int d0_ = q - (kt0 + crow(r + k, hi)), d1_ = d0_ - 32;
            p0[r + k] = ((unsigned)d0_ < 128u) ? p0[r + k] + bb0[k] : NEG; p1[r + k] = ((unsigned)d1_ < 128u) ? p1[r + k] + bb1[k] : NEG; } }
        softmax_tile(p0, p1, m, l, negm, o[0], o[1], q0, q1, wsf, r32, hi);
      } else {
        const bool need_mask = (kt0 + 63 >= qrow0);
        f32x16 l0, l1;
#pragma unroll
        for (int r = 0; r < 16; ++r) {
          { const float e = ex2(-fmaxf(p0[r], -100.f)); float sg = __builtin_amdgcn_rcpf(1.f + e); float fl_ = e * sg; if (need_mask && (kt0 + crow(r, hi) >= q)) { sg = 0.f; fl_ = 1.f; } p0[r] = sg; l0[r] = fl_; }
          { const float e = ex2(-fmaxf(p1[r], -100.f)); float sg = __builtin_amdgcn_rcpf(1.f + e); float fl_ = e * sg; if (need_mask && (kt0 + 32 + crow(r, hi) >= q)) { sg = 0.f; fl_ = 1.f; } p1[r] = sg; l1[r] = fl_; }
        }
        float gs[8], pg[8];
#pragma unroll
        for (int c = 0; c < 4; ++c) { gs[c] = (l0[4 * c] * l0[4 * c + 1]) * (l0[4 * c + 2] * l0[4 * c + 3]); gs[4 + c] = (l1[4 * c] * l1[4 * c + 1]) * (l1[4 * c + 2] * l1[4 * c + 3]); }
#pragma unroll
        for (int ch = 0; ch < 8; ++ch) pg[ch] = __shfl_xor(gs[ch], 32);
        float suf = cp;
#pragma unroll
        for (int ch = 7; ch >= 4; --ch) { float run = (hi == 0) ? suf * pg[ch] : suf;
#pragma unroll
          for (int k = 3; k >= 0; --k) { const int r = 4 * (ch - 4) + k; p1[r] *= run; run *= l1[r]; }
          suf *= gs[ch] * pg[ch]; }
#pragma unroll
        for (int ch = 3; ch >= 0; --ch) { float run = (hi == 0) ? suf * pg[ch] : suf;
#pragma unroll
          for (int k = 3; k >= 0; --k) { const int r = 4 * ch + k; p0[r] *= run; run *= l0[r]; }
          suf *= gs[ch] * pg[ch]; }
        cp = suf;
        wdone = __all(cp == 0.f);
      }
      pw0 = (u32x4){cvtpk(p0[0], p0[1]), cvtpk(p0[2], p0[3]), cvtpk(p0[4], p0[5]), cvtpk(p0[6], p0[7])};
      pw1 = (u32x4){cvtpk(p0[8], p0[9]), cvtpk(p0[10], p0[11]), cvtpk(p0[12], p0[13]), cvtpk(p0[14], p0[15])};
      pw2 = (u32x4){cvtpk(p1[0], p1[1]), cvtpk(p1[2], p1[3]), cvtpk(p1[4], p1[5]), cvtpk(p1[6], p1[7])};
      pw3 = (u32x4){cvtpk(p1[8], p1[9]), cvtpk(p1[10], p1[11]), cvtpk(p1[12], p1[13]), cvtpk(p1[14], p1[15])};
      have_pv = true; pv_sl = sl;
    }
    if (MODE == 1 && lane == 0) fl[((i + 1) & 1) * 8 + wid] = wdone ? 1u : 0u;
    p0 = q0; p1 = q1;
    sl = sln; sln = (sln == L::NSL - 1) ? 0 : sln + 1;
  }
  if (have_pv) pv(o, vb0 + pv_sl * VSLOT, __builtin_bit_cast(bf16x8, pw0), __builtin_bit_cast(bf16x8, pw1), __builtin_bit_cast(bf16x8, pw2), __builtin_bit_cast(bf16x8, pw3));
#undef ATT_TILE
#undef ATT_LOAD
#undef ATT_STAGE
#undef ATT_QK
  float rli[16];
  if (MODE != 1) {
    if (hi == 0) wsf[32 + r32] = l;
#pragma unroll
    for (int r = 0; r < 16; ++r) rli[r] = __builtin_amdgcn_rcpf(wsf[32 + crow(r, hi)]);
  } else {
#pragma unroll
    for (int r = 0; r < 16; ++r) rli[r] = 1.f;
  }
  { LAS bf16* stg = (LAS bf16*)(shm + L::OFF_OST) + wid * 2048;
#pragma unroll
    for (int r = 0; r < 16; ++r) { const int orow = crow(r, hi);
#pragma unroll
      for (int d0 = 0; d0 < 2; ++d0) stg[orow * 64 + d0 * 32 + r32] = f2bf(o[d0][r] * rli[r]); }
    bf16* Ow = A.O + (rowbase + qrow0) * 1024 + head * 64;
#pragma unroll
    for (int i = 0; i < 4; ++i) { const int row = i * 8 + (lane >> 3), ch = lane & 7; const u32x4 v = *(LAS const u32x4*)(stg + row * 64 + ch * 8); *(u32x4*)(Ow + (long)row * 1024 + ch * 8) = v; } }
  asm volatile("s_waitcnt lgkmcnt(0)\n\ts_barrier" ::: "memory");
}

template <int MODE>
__device__ __forceinline__ void attn_phase(LAS char* shm, const Args& A, int G, int c) {
  int prev = -1;
  for (int s = c; s < 2048; s += G) {
    const int cc = s & 255, i = s >> 8;
    int b, hsel, qblk;
    if (MODE == 0) { const int u = cc * 8 + i; b = u >> 8; hsel = (u >> 7) & 1; qblk = u & 127; }
    else { const int bh = cc >> 1, par = cc & 1; b = bh >> 4; hsel = bh & 15;
      if (MODE == 2) qblk = (i & 1) ? 15 - (i - 1) - par : i + par;
      else qblk = 2 * i + par; }
    attn_unit<MODE>(shm, A, b, hsel, qblk, b * 16 + hsel != prev); prev = b * 16 + hsel;
  }
}

template <int MODE>
__device__ __forceinline__ void attn_naive(const Args& A, int G, int c) {
  constexpr int DK = (MODE == 2) ? 96 : 64;
  for (int ch = c; ch < 1024; ch += G) {
    const int b = ch >> 7, head = (ch >> 3) & 15, q = (ch & 7) * 512 + (int)threadIdx.x;
    const int kvh = (MODE == 0) ? head >> 3 : head;
    const long rowbase = (long)b * SEQ;
    float qv[DK];
    { const bf16* qp = A.Q + (rowbase + q) * (long)A.qpitch + head * A.qhs;
#pragma unroll
      for (int d = 0; d < DK; ++d) qv[d] = bf2f(qp[d]); }
    if (MODE == 2) {
#pragma unroll
      for (int i = 0; i < 16; ++i) { const float cs = A.cosT[q * 16 + i], sn = A.sinT[q * 16 + i]; const float x1 = qv[DK - 32 + i], x2 = qv[DK - 16 + i];
        qv[DK - 32 + i] = bf2f(f2bf(x1 * cs - x2 * sn)); qv[DK - 16 + i] = bf2f(f2bf(x1 * sn + x2 * cs)); }
    }
    float o[64];
#pragma unroll
    for (int d = 0; d < 64; ++d) o[d] = 0.f;
    float m = -1e30f, l = 0.f, carry = 0.f;
    if (MODE == 0) { m = A.sinks[head] * LOG2E; l = 1.f; }
    const int nk = (MODE == 0) ? 128 : (MODE == 1 ? q : q + 1);
    for (int j = 0; j < nk; ++j) {
      const int key = (MODE == 0) ? q - j : (MODE == 1 ? q - 1 - j : j);
      if (key < 0) break;
      const bf16* kp = A.K + (rowbase + key) * (long)A.kpitch + kvh * A.khs;
      float s = 0.f;
#pragma unroll
      for (int d = 0; d < 64; ++d) s += qv[d] * bf2f(kp[d]);
      if (MODE == 2) { const bf16* k2 = A.K2 + (rowbase + key) * 32;
#pragma unroll
        for (int d = 0; d < 32; ++d) s += qv[64 + d] * bf2f(k2[d]); }
      const bf16* vp = A.V + (rowbase + key) * (long)A.vpitch + kvh * A.vhs;
      if (MODE == 1) {
        const float lf = -(fmaxf(s, 0.f) + lg2(1.f + ex2(-fabsf(s))));
        const float a = ex2(s + lf + carry); carry += lf;
#pragma unroll
        for (int d = 0; d < 64; ++d) o[d] += a * bf2f(vp[d]);
        if (carry < -152.f) break;
      } else {
        if (MODE == 0) { const int dist = j; int bk = dist; if (dist >= 16) { bk = 16 + (int)(__logf((float)dist * (1.f / 16.f)) * (16.f / 2.0794415416798357f)); bk = bk > 31 ? 31 : bk; } s += A.relb[bk * 16 + head] * LOG2E; }
        const float mn = fmaxf(m, s), f = ex2(m - mn), p = ex2(s - mn); l = l * f + p; m = mn;
#pragma unroll
        for (int d = 0; d < 64; ++d) o[d] = o[d] * f + p * bf2f(vp[d]);
      }
    }
    const float rl = (MODE == 1) ? 1.f : 1.f / l;
    bf16* op = A.O + (rowbase + q) * 1024 + head * 64;
#pragma unroll
    for (int d = 0; d < 64; ++d) op[d] = f2bf(o[d] * rl);
  }
}
#undef ATT_SBAR
}

constexpr int NWAVES = 8;
constexpr int BATCH = 8, SEQ = 4096, D = 1024, T = BATCH * SEQ;
constexpr int FFN = 2816, NEXP = 8, EDIM = 3584, PMAX = 67584;
constexpr int SWA_N = 1280, SB_N = 3072, MLA_DN = 768, MLA_QR = 384, MLA_KVR = 256, MLA_UQN = 1536, MLA_UKVN = 2048;
constexpr float RMS_EPS = 1e-6f, LOG2E = 1.4426950408889634f;
constexpr int NPH = 34;
typedef unsigned short bf16;
typedef unsigned v4u __attribute__((ext_vector_type(4)));
typedef unsigned v2u __attribute__((ext_vector_type(2)));
typedef float f32x4 __attribute__((ext_vector_type(4)));
typedef float f32x2 __attribute__((ext_vector_type(2)));
typedef int i32x2 __attribute__((ext_vector_type(2)));
typedef GAS unsigned gu32;
#define RLX_AGENT __ATOMIC_RELAXED, __HIP_MEMORY_SCOPE_AGENT
#define LDS_WAIT() asm volatile("s_waitcnt lgkmcnt(0)" ::: "memory")

constexpr size_t MiB = 1u << 20;
constexpr size_t WS_CTL = 0, CTL_ZERO_BYTES = 1 * MiB;
constexpr size_t WS_TAB = 1 * MiB;
constexpr size_t TAB_COS = 0, TAB_SIN = 256 * 1024, TAB_TOKE = 512 * 1024, TAB_TOKG = 640 * 1024, TAB_SLOT = 896 * 1024, TAB_SA = 1152 * 1024, TAB_SAP = 1280 * 1024, TAB_SB = 1600 * 1024, TAB_WCNT = 2200 * 1024;
constexpr size_t WS_WSM = 4 * MiB;
constexpr size_t WS_WMOE = 44 * MiB;
constexpr size_t WS_H = 156 * MiB;
constexpr size_t WS_SCR = 220 * MiB;
constexpr size_t WS_YP = 814 * MiB;
constexpr size_t YP_ELEMS = (size_t)2048 * 1024;
constexpr size_t WS_END = 842 * MiB;
constexpr size_t B_SWAO = 0, B_SBO = 4194304, B_MLAUQ = 6291456, B_MLAUKV = 7471104, B_MLAO = 8519680, B_FFND = 10616832,
                 B_SWAQKV = 22151168, B_SBQKV = 24772608, B_MLAD = 27918336, B_FFNGU = 28704768, B_SM_END = 40239104;
static_assert(B_SM_END <= 40 * MiB, "small weights fit");
constexpr size_t B_MOEGU_E = (size_t)2 * EDIM * D, B_MOED = 8 * B_MOEGU_E, B_MOED_E = (size_t)D * EDIM * 2;
static_assert(B_MOED + 8 * B_MOED_E <= 112 * MiB, "moe weights fit");
constexpr int SBO_SWAQKV = 0, SBO_SBQKV = 2560, SBO_MLAD = 5632, SBO_FFNGU = 6400, SBO_MOE = 17664, SBO_END = 17664 + 2 * 57344;
constexpr size_t SC_QKV = 0;
constexpr size_t SC_C = 0, SC_CQN = 48 * MiB, SC_CKVN = 72 * MiB, SC_KROPE = 88 * MiB, SC_QM = 90 * MiB, SC_KVM = 186 * MiB;
constexpr size_t SC_DELTA = 320 * MiB;
constexpr size_t SC_ACT = 0;
constexpr size_t SC_HPERM = 0, SC_MACT = 132 * MiB;
static_assert(SC_MACT + (size_t)PMAX * EDIM * 2 <= 594 * MiB && SC_KVM + (size_t)T * MLA_UKVN * 2 <= 594 * MiB, "scratch fits");
constexpr int CW_BAR = 4096, CW_CNT = 16384, CW_CUR = 16384 + 256, CW_AMAX = 32768;
static_assert((CW_AMAX + SBO_END) * 4 <= (int)CTL_ZERO_BYTES && TAB_SB + (size_t)SBO_END * 4 <= TAB_WCNT && TAB_WCNT + 2 * 4096 * 8 <= 3 * MiB, "ctl / tab maps");

__device__ __forceinline__ unsigned f2bf(float f) { unsigned u = __builtin_bit_cast(unsigned, f); return (u + 0x7fffu + ((u >> 16) & 1u)) >> 16; }
__device__ __forceinline__ unsigned pk2(float lo, float hi) { return f2bf(lo) | (f2bf(hi) << 16); }
__device__ __forceinline__ float bflo(unsigned w) { return __builtin_bit_cast(float, w << 16); }
__device__ __forceinline__ float bfhi(unsigned w) { return __builtin_bit_cast(float, w & 0xffff0000u); }
#define XB_TMO      128
#define XB_XCNT(j)  (256  + 64 * (j))
#define XB_XSUB(j)  (1280 + 64 * (j))
#define XB_XGEN(j)  (2304 + 64 * (j))
#define XB_TOP      3328
#define XB_TOPGEN   3392
#define XCD_BAR_WORDS 3456
#define XB_SPIN_CAP (1u << 18)

__device__ __forceinline__ unsigned xb_ld(unsigned* p)              { return __hip_atomic_load(p, __ATOMIC_RELAXED, __HIP_MEMORY_SCOPE_AGENT); }
__device__ __forceinline__ unsigned xb_add(unsigned* p, unsigned v) { return __hip_atomic_fetch_add(p, v, __ATOMIC_RELAXED, __HIP_MEMORY_SCOPE_AGENT); }
__device__ __forceinline__ unsigned xb_xcc_id() { return (unsigned)__builtin_amdgcn_s_getreg((3 << 11) | 20) & 0xFu; }
#define XB_SPIN(cond, bar) do { unsigned _sp = 0; while (cond) { __builtin_amdgcn_s_sleep(1); \
    if ((++_sp & 255u) == 0u) { if (xb_ld(&(bar)[XB_TMO])) break; if (_sp > XB_SPIN_CAP) { atomicAdd(&(bar)[XB_TMO], 1u); break; } } } } while (0)

struct XcdBarrier {
    unsigned* bar; unsigned x;
    volatile LAS unsigned* st;
};

__device__ __forceinline__ XcdBarrier xcd_barrier_post(unsigned* bar, volatile LAS unsigned* st) {
    XcdBarrier b; b.bar = bar; b.x = xb_xcc_id(); b.st = st;
    if (threadIdx.x == 0) (void)xb_add(&bar[XB_XCNT(b.x)], 1u);
    return b;
}
__device__ __forceinline__ void xcd_barrier_complete(unsigned* bar, unsigned x, unsigned& nloc, unsigned& nx) {
    const unsigned G = gridDim.x * gridDim.y * gridDim.z;
    unsigned sum, cnt, mine, sp = 0u;
    for (;;) {
        sum = 0u; cnt = 0u; mine = 0u;
#pragma unroll
        for (unsigned j = 0; j < 16; ++j) { const unsigned c = xb_ld(&bar[XB_XCNT(j)]); sum += c; cnt += (c > 0u) ? 1u : 0u; mine = (j == x) ? c : mine; }
        if (sum == G) break;
        __builtin_amdgcn_s_sleep(1);
        if ((++sp & 255u) == 0u) { if (xb_ld(&bar[XB_TMO])) break; if (sp > XB_SPIN_CAP) { atomicAdd(&bar[XB_TMO], 1u); break; } }
    }
    nloc = mine > 0u ? mine : 1u; nx = cnt > 0u ? cnt : 1u;
}

__device__ __forceinline__ void xcd_barrier(const XcdBarrier& b) {
    asm volatile("s_waitcnt vmcnt(0)" ::: "memory");
    __syncthreads();
    if (threadIdx.x == 0) {
        unsigned* bar = b.bar;
        __builtin_amdgcn_s_waitcnt(0);
        unsigned nloc = b.st[0], nx = b.st[1];
        if (nloc == 0u) { xcd_barrier_complete(bar, b.x, nloc, nx); b.st[0] = nloc; b.st[1] = nx; }
        const unsigned old = xb_add(&bar[XB_XSUB(b.x)], 1u);
        const unsigned gen = old / nloc;
        if (old + 1u == (gen + 1u) * nloc) {
            __builtin_amdgcn_fence(__ATOMIC_RELEASE, "agent");
            asm volatile("s_waitcnt vmcnt(0)" ::: "memory");
            const unsigned og = xb_add(&bar[XB_TOP], 1u);
            const unsigned tg = og / nx;
            if (og + 1u == (tg + 1u) * nx) xb_add(&bar[XB_TOPGEN], 1u);
            else XB_SPIN(xb_ld(&bar[XB_TOPGEN]) == tg, bar);
            __builtin_amdgcn_fence(__ATOMIC_ACQUIRE, "agent");
            xb_add(&bar[XB_XGEN(b.x)], 1u);
            asm volatile("s_waitcnt vmcnt(0)" ::: "memory");
        } else {
            XB_SPIN(xb_ld(&bar[XB_XGEN(b.x)]) == gen, bar);
            __builtin_amdgcn_fence(__ATOMIC_ACQUIRE, "agent");
            asm volatile("s_waitcnt vmcnt(0)" ::: "memory");
        }
    }
    __syncthreads();
}

struct Frame {
    LAS unsigned char* lds;
    gu32* ctl;
    int tid, lane, wave, G, gw, NGW;
    unsigned char* ws;
};
__device__ __forceinline__ float wave_sum(float v) {
#pragma unroll
    for (int o = 1; o < 64; o <<= 1) v += __shfl_xor(v, o);
    return v;
}
__device__ __forceinline__ void transpose_item(const float* W, int K, int N, bf16* WT, int rs, int off, LAS float* scr, int item, int lane) {
    const int nblk = N / 32, kb = item / nblk, nb = item % nblk, k0 = 64 * kb, n0 = 32 * nb;
#pragma unroll 8
    for (int i = 0; i < 32; ++i) { const int kk = 2 * i + (lane >> 5); scr[kk * 33 + (lane & 31)] = W[(size_t)(k0 + kk) * N + n0 + (lane & 31)]; }
    LDS_WAIT(); asm volatile("" ::: "memory");
    const int c = lane & 7;
#pragma unroll
    for (int j = 0; j < 4; ++j) { const int n = (lane >> 3) + 8 * j; const LAS float* s = scr + (8 * c) * 33 + n;
        v4u o; o.x = pk2(s[0 * 33], s[1 * 33]); o.y = pk2(s[2 * 33], s[3 * 33]); o.z = pk2(s[4 * 33], s[5 * 33]); o.w = pk2(s[6 * 33], s[7 * 33]);
        const int ng = n0 + n, drow = (ng >> 7) * rs + (ng & 127) + off;
        *(v4u*)(WT + (size_t)drow * K + k0 + 8 * c) = o; }
    LDS_WAIT(); asm volatile("" ::: "memory");
}
#define NI(K_, N_) (((K_) / 64) * ((N_) / 32))
__device__ __forceinline__ void quant_slab(Frame& F, const float* W, int N, signed char* WT, float* sB, int rs, int off, int slab) {
    constexpr int PITCH = 1028;
    LAS unsigned char* Tt = F.lds; LAS float* red = (LAS float*)(F.lds + 64 * PITCH);
    const int w = F.wave, l = F.lane, g = l >> 4, c4 = l & 15, n0 = slab * 64, nc = n0 + 4 * c4;
    const bool live = nc < N;
    f32x4 v[8][4];
#pragma unroll
    for (int P = 0; P < 8; ++P)
#pragma unroll
        for (int j = 0; j < 4; ++j) { const int r = 128 * P + 16 * w + 4 * g + j; v[P][j] = live ? *(const f32x4*)(W + (size_t)r * N + nc) : (f32x4){0.f, 0.f, 0.f, 0.f}; }
    f32x4 mx = (f32x4){0.f, 0.f, 0.f, 0.f};
#pragma unroll
    for (int P = 0; P < 8; ++P)
#pragma unroll
        for (int j = 0; j < 4; ++j) { mx.x = fmaxf(mx.x, fabsf(v[P][j].x)); mx.y = fmaxf(mx.y, fabsf(v[P][j].y)); mx.z = fmaxf(mx.z, fabsf(v[P][j].z)); mx.w = fmaxf(mx.w, fabsf(v[P][j].w)); }
#pragma unroll
    for (int o = 16; o < 64; o <<= 1) { mx.x = fmaxf(mx.x, __shfl_xor(mx.x, o)); mx.y = fmaxf(mx.y, __shfl_xor(mx.y, o)); mx.z = fmaxf(mx.z, __shfl_xor(mx.z, o)); mx.w = fmaxf(mx.w, __shfl_xor(mx.w, o)); }
    if (g == 0) *(LAS f32x4*)(red + w * 64 + 4 * c4) = mx;
    __syncthreads();
#pragma unroll
    for (int ww = 0; ww < 8; ++ww) { const f32x4 t = *(const LAS f32x4*)(red + ww * 64 + 4 * c4); mx.x = fmaxf(mx.x, t.x); mx.y = fmaxf(mx.y, t.y); mx.z = fmaxf(mx.z, t.z); mx.w = fmaxf(mx.w, t.w); }
    f32x4 inv; inv.x = mx.x > 0.f ? 127.f / mx.x : 0.f; inv.y = mx.y > 0.f ? 127.f / mx.y : 0.f; inv.z = mx.z > 0.f ? 127.f / mx.z : 0.f; inv.w = mx.w > 0.f ? 127.f / mx.w : 0.f;
#pragma unroll
    for (int P = 0; P < 8; ++P) {
        unsigned wd[4];
#pragma unroll
        for (int i = 0; i < 4; ++i) { const float s = (i == 0) ? inv.x : (i == 1) ? inv.y : (i == 2) ? inv.z : inv.w;
            const int q0 = (int)__builtin_rintf(v[P][0][i] * s), q1 = (int)__builtin_rintf(v[P][1][i] * s), q2 = (int)__builtin_rintf(v[P][2][i] * s), q3 = (int)__builtin_rintf(v[P][3][i] * s);
            wd[i] = (unsigned)(q0 & 0xff) | ((unsigned)(q1 & 0xff) << 8) | ((unsigned)(q2 & 0xff) << 16) | ((unsigned)(q3 & 0xff) << 24); }
#pragma unroll
        for (int i = 0; i < 4; ++i) *(LAS unsigned*)(Tt + (4 * c4 + i) * PITCH + 128 * P + 16 * w + 4 * g) = wd[i];
    }
    if (w == 0 && g == 0 && live) {
#pragma unroll
        for (int i = 0; i < 4; ++i) { const int ng = nc + i, drow = (ng >> 7) * rs + (ng & 127) + off; sB[drow] = ((i == 0) ? mx.x : (i == 1) ? mx.y : (i == 2) ? mx.z : mx.w) * (1.f / 127.f); }
    }
    __syncthreads();
#pragma unroll
    for (int k = 0; k < 8; ++k) { const int n = 8 * w + k, ng = n0 + n;
        if (ng < N) { const LAS unsigned* sp = (const LAS unsigned*)(Tt + n * PITCH + 16 * l); const v4u o = (v4u){sp[0], sp[1], sp[2], sp[3]};
            const int drow = (ng >> 7) * rs + (ng & 127) + off; *((v4u*)(WT + (size_t)drow * D) + l) = o; } }
    __syncthreads();
}
__device__ __forceinline__ void quant_small(Frame& F, const float* const* in) {
    signed char* WB = (signed char*)(F.ws + WS_WSM); float* SB = (float*)(F.ws + WS_TAB + TAB_SB);
    constexpr int NSL = 2 * 20 + 48 + 11 + 4 * 44;
    for (int it = blockIdx.x; it < NSL; it += F.G) {
        int r = it; bool found = false; const float* W = nullptr; signed char* WT = nullptr; int N = 0, rs = 128, off = 0, so = 0;
#define JOB(Wp, WTp, N_, RS, OFF, SO) if (!found) { const int ni = ((N_) + 63) / 64; if (r < ni) { W = (Wp); WT = (WTp); N = (N_); rs = (RS); off = (OFF); so = (SO); found = true; } else r -= ni; }
        JOB(in[5], WB + B_SWAQKV, SWA_N, 128, 0, SBO_SWAQKV)
        JOB(in[5] + (size_t)D * SWA_N, WB + B_SWAQKV + (size_t)SWA_N * D, SWA_N, 128, 0, SBO_SWAQKV + SWA_N)
        JOB(in[9], WB + B_SBQKV, SB_N, 128, 0, SBO_SBQKV)
        JOB(in[11], WB + B_MLAD, 672, 128, 0, SBO_MLAD)
        JOB(in[17], WB + B_FFNGU, FFN, 256, 0, SBO_FFNGU)
        JOB(in[18], WB + B_FFNGU, FFN, 256, 128, SBO_FFNGU)
        JOB(in[17] + (size_t)D * FFN, WB + B_FFNGU + (size_t)2 * FFN * D, FFN, 256, 0, SBO_FFNGU + 2 * FFN)
        JOB(in[18] + (size_t)D * FFN, WB + B_FFNGU + (size_t)2 * FFN * D, FFN, 256, 128, SBO_FFNGU + 2 * FFN)
#undef JOB
        if (found) quant_slab(F, W, N, WT, SB + so, rs, off, r);
    }
}
__device__ __forceinline__ void quant_moe_gu(Frame& F, const float* wg, const float* wu, int f) {
    signed char* WM = (signed char*)(F.ws + WS_WMOE); float* SB = (float*)(F.ws + WS_TAB + TAB_SB) + SBO_MOE + f * 57344;
    constexpr int PER = EDIM / 64;
    for (int it = blockIdx.x; it < 16 * PER; it += F.G) {
        const int which = it / PER, r = it % PER, e = which >> 1, up = which & 1;
        quant_slab(F, (up ? wu : wg) + (size_t)e * D * EDIM, EDIM, WM + (size_t)e * B_MOEGU_E, SB + e * 7168, 256, up * 128, r);
    }
}
__device__ __forceinline__ void convert_small_bf16(Frame& F, const float* const* in) {
    LAS float* scr = (LAS float*)(F.lds + F.wave * 16384);
    unsigned char* WB = F.ws + WS_WSM;
    constexpr int NITEMS = 4 * NI(D, D) + NI(MLA_QR, MLA_UQN) + NI(MLA_KVR, MLA_UKVN) + 2 * NI(FFN, D);
    for (int it = F.gw; it < NITEMS; it += F.NGW) {
        int r = it; bool found = false; const float* W = nullptr; bf16* WT = nullptr; int K = 0, N = 0;
#define JOB(Wp, WTp, K_, N_) if (!found) { const int ni = NI(K_, N_); if (r < ni) { W = (Wp); WT = (bf16*)(WTp); K = (K_); N = (N_); found = true; } else r -= ni; }
        JOB(in[8], WB + B_SWAO, D, D)
        JOB(in[8] + (size_t)D * D, WB + B_SWAO + (size_t)D * D * 2, D, D)
        JOB(in[10], WB + B_SBO, D, D)
        JOB(in[16], WB + B_MLAO, D, D)
        JOB(in[13], WB + B_MLAUQ, MLA_QR, MLA_UQN)
        JOB(in[15], WB + B_MLAUKV, MLA_KVR, MLA_UKVN)
        JOB(in[19], WB + B_FFND, FFN, D)
        JOB(in[19] + (size_t)FFN * D, WB + B_FFND + (size_t)D * FFN * 2, FFN, D)
#undef JOB
        if (found) transpose_item(W, K, N, WT, 128, 0, scr, r, F.lane);
    }
    for (int i = F.gw * 64 + F.lane; i < SEQ * 16; i += F.NGW * 64) {
        const int pos = i >> 4, fi = i & 15;
        const double inv = exp2(-(double)fi * (13.287712379549449 / 16.0));
        const double turns = (double)pos * inv * 0.15915494309189535;
        const float fr = (float)(turns - floor(turns));
        ((float*)(F.ws + WS_TAB + TAB_COS))[i] = __builtin_amdgcn_cosf(fr);
        ((float*)(F.ws + WS_TAB + TAB_SIN))[i] = __builtin_amdgcn_sinf(fr);
    }
}
__device__ __forceinline__ void convert_moe_down(Frame& F, const float* wd) {
    LAS float* scr = (LAS float*)(F.lds + F.wave * 16384);
    constexpr int PER = NI(EDIM, D);
    for (int it = F.gw; it < 8 * PER; it += F.NGW) { const int e = it / PER, r = it % PER;
        transpose_item(wd + (size_t)e * EDIM * D, EDIM, D, (bf16*)(F.ws + WS_WMOE + B_MOED + (size_t)e * B_MOED_E), 128, 0, scr, r, F.lane); }
}
#undef NI
__device__ __forceinline__ void zero_mlad_pad(Frame& F) {
    for (int i = F.gw * 64 + F.lane; i < 96 * 1024 / 16; i += F.NGW * 64) *(v4u*)(F.ws + WS_WSM + B_MLAD + (size_t)672 * D + (size_t)i * 16) = (v4u){0u, 0u, 0u, 0u};
    float* SB = (float*)(F.ws + WS_TAB + TAB_SB) + SBO_MLAD;
    for (int i = F.gw * 64 + F.lane; i < 96; i += F.NGW * 64) SB[672 + i] = 0.f;
}
__device__ __forceinline__ void quant_row_store(const f32x4 (&v)[4], signed char* h8row, float* sa, int lane) {
    float mx = 0.f;
#pragma unroll
    for (int j = 0; j < 4; ++j) mx = fmaxf(mx, fmaxf(fmaxf(fabsf(v[j].x), fabsf(v[j].y)), fmaxf(fabsf(v[j].z), fabsf(v[j].w))));
#pragma unroll
    for (int o = 1; o < 64; o <<= 1) mx = fmaxf(mx, __shfl_xor(mx, o));
    const float inv = mx > 0.f ? 127.f / mx : 0.f;
    unsigned* o4 = (unsigned*)h8row + lane;
#pragma unroll
    for (int j = 0; j < 4; ++j) { const int q0 = (int)__builtin_rintf(v[j].x * inv), q1 = (int)__builtin_rintf(v[j].y * inv), q2 = (int)__builtin_rintf(v[j].z * inv), q3 = (int)__builtin_rintf(v[j].w * inv);
        o4[64 * j] = (unsigned)(q0 & 0xff) | ((unsigned)(q1 & 0xff) << 8) | ((unsigned)(q2 & 0xff) << 16) | ((unsigned)(q3 & 0xff) << 24); }
    if (lane == 0) *sa = mx * (1.f / 127.f);
}
__device__ __forceinline__ void norm_phase(Frame& F, const float* src, const bf16* delta, float* xout, const float* g, signed char* h8, float* sa) {
    f32x4 gv[4];
#pragma unroll
    for (int j = 0; j < 4; ++j) gv[j] = ((const f32x4*)g)[F.lane + 64 * j];
    f32x4 vn[4];
    if (F.gw < T) { const f32x4* xr = (const f32x4*)(src + (size_t)F.gw * D) + F.lane;
#pragma unroll
        for (int j = 0; j < 4; ++j) vn[j] = xr[64 * j]; }
    for (int m = F.gw; m < T; m += F.NGW) {
        f32x4 v[4]; float ss = 0.f;
#pragma unroll
        for (int j = 0; j < 4; ++j) v[j] = vn[j];
        if (m + F.NGW < T) { const f32x4* xr = (const f32x4*)(src + (size_t)(m + F.NGW) * D) + F.lane;
#pragma unroll
            for (int j = 0; j < 4; ++j) vn[j] = xr[64 * j]; }
        if (delta) { const v2u* dr = (const v2u*)(delta + (size_t)m * D) + F.lane; f32x4* xo = (f32x4*)(xout + (size_t)m * D) + F.lane;
#pragma unroll
            for (int j = 0; j < 4; ++j) { const v2u a = dr[64 * j]; v[j].x += bflo(a.x); v[j].y += bfhi(a.x); v[j].z += bflo(a.y); v[j].w += bfhi(a.y); xo[64 * j] = v[j]; } }
#pragma unroll
        for (int j = 0; j < 4; ++j) ss += (v[j].x * v[j].x + v[j].y * v[j].y) + (v[j].z * v[j].z + v[j].w * v[j].w);
        const float rstd = rsqrtf(wave_sum(ss) * (1.f / D) + RMS_EPS);
#pragma unroll
        for (int j = 0; j < 4; ++j) v[j] = v[j] * rstd * gv[j];
        quant_row_store(v, h8 + (size_t)m * D, sa + m, F.lane);
    }
}
__device__ __forceinline__ void norm_route_phase(Frame& F, float* src, const bf16* delta, const float* g, signed char* h8, float* sa, const float* router, int layer) {
    LAS float* Rt = (LAS float*)F.lds;
    for (int i = F.tid; i < D * NEXP; i += NWAVES * 64) { const int k = i >> 3, e = i & 7; Rt[e * D + k] = router[i]; }
    __syncthreads();
    f32x4 gv[4];
#pragma unroll
    for (int j = 0; j < 4; ++j) gv[j] = ((const f32x4*)g)[F.lane + 64 * j];
    int* tok_e = (int*)(F.ws + WS_TAB + TAB_TOKE); f32x2* tok_g = (f32x2*)(F.ws + WS_TAB + TAB_TOKG);
    unsigned long long cnt = 0ull;
    f32x4 vn[4];
    if (F.gw < T) { const f32x4* xn = (const f32x4*)(src + (size_t)F.gw * D) + F.lane;
#pragma unroll
        for (int j = 0; j < 4; ++j) vn[j] = xn[64 * j]; }
    for (int m = F.gw; m < T; m += F.NGW) {
        f32x4* xr = (f32x4*)(src + (size_t)m * D) + F.lane;
        f32x4 v[4]; float ss = 0.f;
#pragma unroll
        for (int j = 0; j < 4; ++j) v[j] = vn[j];
        if (m + F.NGW < T) { const f32x4* xn = (const f32x4*)(src + (size_t)(m + F.NGW) * D) + F.lane;
#pragma unroll
            for (int j = 0; j < 4; ++j) vn[j] = xn[64 * j]; }
        if (delta) { const v2u* dr = (const v2u*)(delta + (size_t)m * D) + F.lane;
#pragma unroll
            for (int j = 0; j < 4; ++j) { const v2u a = dr[64 * j]; v[j].x += bflo(a.x); v[j].y += bfhi(a.x); v[j].z += bflo(a.y); v[j].w += bfhi(a.y); xr[64 * j] = v[j]; } }
#pragma unroll
        for (int j = 0; j < 4; ++j) ss += (v[j].x * v[j].x + v[j].y * v[j].y) + (v[j].z * v[j].z + v[j].w * v[j].w);
        const float rstd = rsqrtf(wave_sum(ss) * (1.f / D) + RMS_EPS);
#pragma unroll
        for (int j = 0; j < 4; ++j) v[j] = v[j] * rstd * gv[j];
        quant_row_store(v, h8 + (size_t)m * D, sa + m, F.lane);
        float lg[8];
#pragma unroll
        for (int e = 0; e < 8; ++e) { float a = 0.f;
#pragma unroll
            for (int j = 0; j < 4; ++j) { const f32x4 r = *(const LAS f32x4*)(Rt + e * D + 256 * j + 4 * F.lane); a += (v[j].x * r.x + v[j].y * r.y) + (v[j].z * r.z + v[j].w * r.w); }
            lg[e] = wave_sum(a); }
        int e1 = 0; float v1 = lg[0];
#pragma unroll
        for (int e = 1; e < 8; ++e) if (lg[e] > v1) { v1 = lg[e]; e1 = e; }
        int e2 = -1; float v2 = -3.0e38f;
#pragma unroll
        for (int e = 0; e < 8; ++e) if (e != e1 && lg[e] > v2) { v2 = lg[e]; e2 = e; }
        const float g1 = 1.f / (1.f + __expf(v2 - v1)), g2 = 1.f - g1;
        if (F.lane == 0) { tok_e[m] = e1 | (e2 << 8); tok_g[m] = (f32x2){g1, g2}; }
        cnt += (1ull << (8 * e1)) + (1ull << (8 * e2));
    }
    if (F.lane < 8) { const unsigned c = (unsigned)(cnt >> (8 * F.lane)) & 0xffu; if (c) __hip_atomic_fetch_add((unsigned*)(F.ctl + CW_CNT + 64 * layer) + F.lane, c, RLX_AGENT); }
    if (F.lane == 0) ((unsigned long long*)(F.ws + WS_TAB + TAB_WCNT))[layer * 4096 + F.gw] = cnt;
    __syncthreads();
}
struct MoeLayout { int poff[8]; int tp[9]; };
__device__ __forceinline__ MoeLayout moe_layout(Frame& F, int layer) {
    MoeLayout L; int acc = 0; L.tp[0] = 0;
#pragma unroll
    for (int e = 0; e < 8; ++e) { const int c = (int)__builtin_amdgcn_readfirstlane(__hip_atomic_load((unsigned*)(F.ctl + CW_CNT + 64 * layer) + e, RLX_AGENT)); L.poff[e] = acc * 256; acc += (c + 255) >> 8; L.tp[e + 1] = acc; }
    return L;
}
__device__ __forceinline__ void route_assign_phase(Frame& F, const signed char* h8, const float* sa, signed char* hperm, float* sap, int layer) {
    const MoeLayout L = moe_layout(F, layer);
    const int* tok_e = (const int*)(F.ws + WS_TAB + TAB_TOKE); int* tok_slot = (int*)(F.ws + WS_TAB + TAB_SLOT);
    const unsigned long long* wcnt = (const unsigned long long*)(F.ws + WS_TAB + TAB_WCNT) + layer * 4096;
    int base[8];
#pragma unroll
    for (int e = 0; e < 8; ++e) base[e] = 0;
    for (int g2 = F.lane; g2 < F.gw; g2 += 64) { const unsigned long long c = wcnt[g2];
#pragma unroll
        for (int e = 0; e < 8; ++e) base[e] += (int)((c >> (8 * e)) & 0xffull); }
#pragma unroll
    for (int e = 0; e < 8; ++e) { int v = base[e];
#pragma unroll
        for (int o = 1; o < 64; o <<= 1) v += __shfl_xor(v, o);
        base[e] = L.poff[e] + v; }
    const int nmine = (T - F.gw + F.NGW - 1) / F.NGW;
    for (int k0 = 0; k0 < nmine; k0 += 16) {
        const int kk = k0 + (F.lane & 15), k = (F.lane >> 4) & 1;
        const bool act = F.lane < 32 && kk < nmine;
        const int tok = act ? F.gw + kk * F.NGW : 0;
        int my_e = 255;
        if (act) my_e = (tok_e[tok] >> (8 * k)) & 0xff;
        int slot = 0;
#pragma unroll
        for (int e = 0; e < 8; ++e) {
            const unsigned long long m1 = __ballot(my_e == e);
            const unsigned lo = (unsigned)m1 & 0xffffu, hi = ((unsigned)m1 >> 16) & 0xffffu;
            const unsigned r = F.lane & 15, below = (1u << r) - 1u;
            const int rank = __popc(lo & below) + __popc(hi & below);
            if (my_e == e) slot = base[e] + rank;
            base[e] += __popc(lo) + __popc(hi);
        }
        if (act) { tok_slot[tok * 2 + k] = slot; sap[slot] = sa[tok]; }
#pragma unroll 8
        for (int j = 0; j < 32; ++j) {
            const int tj = __shfl(tok, j), sj = __shfl(slot, j), aj = __shfl((int)act, j);
            if (aj) *((v4u*)(hperm + (size_t)sj * D) + F.lane) = *((const v4u*)(h8 + (size_t)tj * D) + F.lane);
        }
    }
}
template <bool FINAL>
__device__ __forceinline__ void combine_norm_phase(Frame& F, float* xres, const bf16* y, const float* g, signed char* h8, float* sa) {
    const bf16* yp = (const bf16*)(F.ws + WS_YP);
    f32x4 gv[4];
#pragma unroll
    for (int j = 0; j < 4; ++j) gv[j] = ((const f32x4*)g)[F.lane + 64 * j];
    const i32x2* tok_slot = (const i32x2*)(F.ws + WS_TAB + TAB_SLOT); const f32x2* tok_g = (const f32x2*)(F.ws + WS_TAB + TAB_TOKG);
    i32x2 sln = {0, 0}; f32x2 ggn = {0.f, 0.f}; f32x4 vn[4];
    if (F.gw < T) { sln = tok_slot[F.gw]; ggn = tok_g[F.gw]; const f32x4* xn = (const f32x4*)(xres + (size_t)F.gw * D) + F.lane;
#pragma unroll
        for (int j = 0; j < 4; ++j) vn[j] = xn[64 * j]; }
    for (int m = F.gw; m < T; m += F.NGW) {
        const i32x2 sl = sln; const f32x2 gg = ggn;
        f32x4* xr = (f32x4*)(xres + (size_t)m * D) + F.lane;
        f32x4 v[4]; float ss = 0.f;
#pragma unroll
        for (int j = 0; j < 4; ++j) v[j] = vn[j];
        if (m + F.NGW < T) { sln = tok_slot[m + F.NGW]; ggn = tok_g[m + F.NGW]; const f32x4* xn = (const f32x4*)(xres + (size_t)(m + F.NGW) * D) + F.lane;
#pragma unroll
            for (int j = 0; j < 4; ++j) vn[j] = xn[64 * j]; }
#pragma unroll
        for (int k = 0; k < 2; ++k) { const int slot = k ? sl.y : sl.x; const float gk = k ? gg.y : gg.x;
            if (slot < 65536) { const v2u* yr = (const v2u*)(y + (size_t)slot * D) + F.lane;
#pragma unroll
                for (int j = 0; j < 4; ++j) { const v2u a = yr[64 * j]; v[j].x += gk * bflo(a.x); v[j].y += gk * bfhi(a.x); v[j].z += gk * bflo(a.y); v[j].w += gk * bfhi(a.y); } }
            else { f32x4 t[4];
#pragma unroll
                for (int j = 0; j < 4; ++j) t[j] = (f32x4){0.f, 0.f, 0.f, 0.f};
                for (int p = 0; p < 7; ++p) { const v2u* yr = (const v2u*)(yp + (size_t)p * YP_ELEMS + (size_t)(slot - 65536) * D) + F.lane;
#pragma unroll
                    for (int j = 0; j < 4; ++j) { const v2u a = yr[64 * j]; t[j].x += bflo(a.x); t[j].y += bfhi(a.x); t[j].z += bflo(a.y); t[j].w += bfhi(a.y); } }
#pragma unroll
                for (int j = 0; j < 4; ++j) v[j] = v[j] + t[j] * gk; } }
#pragma unroll
        for (int j = 0; j < 4; ++j) ss += (v[j].x * v[j].x + v[j].y * v[j].y) + (v[j].z * v[j].z + v[j].w * v[j].w);
        const float rstd = rsqrtf(wave_sum(ss) * (1.f / D) + RMS_EPS);
        if (FINAL) {
#pragma unroll
            for (int j = 0; j < 4; ++j) xr[64 * j] = v[j] * rstd * gv[j];
        } else {
#pragma unroll
            for (int j = 0; j < 4; ++j) { xr[64 * j] = v[j]; v[j] = v[j] * rstd * gv[j]; }
            quant_row_store(v, h8 + (size_t)m * D, sa + m, F.lane);
        }
    }
}
__device__ __forceinline__ void mla_cnorm_phase(Frame& F, const bf16* c, const float* qn, const float* kvn, bf16* cqn, bf16* ckvn, bf16* krope) {
    const float* cosT = (const float*)(F.ws + WS_TAB + TAB_COS); const float* sinT = (const float*)(F.ws + WS_TAB + TAB_SIN);
    float gq[6], gk[4];
#pragma unroll
    for (int j = 0; j < 6; ++j) gq[j] = qn[F.lane + 64 * j];
#pragma unroll
    for (int j = 0; j < 4; ++j) gk[j] = kvn[F.lane + 64 * j];
    for (int m = F.gw; m < T; m += F.NGW) {
        const bf16* cr = c + (size_t)m * MLA_DN;
        float a[6], b[4]; float sa = 0.f, sb = 0.f;
#pragma unroll
        for (int j = 0; j < 6; ++j) { a[j] = bflo((unsigned)cr[F.lane + 64 * j]); sa += a[j] * a[j]; }
#pragma unroll
        for (int j = 0; j < 4; ++j) { b[j] = bflo((unsigned)cr[MLA_QR + F.lane + 64 * j]); sb += b[j] * b[j]; }
        const float kr = bflo((unsigned)cr[MLA_QR + MLA_KVR + (F.lane & 31)]);
        const float ra = rsqrtf(wave_sum(sa) * (1.f / MLA_QR) + RMS_EPS), rb = rsqrtf(wave_sum(sb) * (1.f / MLA_KVR) + RMS_EPS);
#pragma unroll
        for (int j = 0; j < 6; ++j) cqn[(size_t)m * MLA_QR + F.lane + 64 * j] = (bf16)f2bf(a[j] * ra * gq[j]);
#pragma unroll
        for (int j = 0; j < 4; ++j) ckvn[(size_t)m * MLA_KVR + F.lane + 64 * j] = (bf16)f2bf(b[j] * rb * gk[j]);
        const float pr = __shfl_xor(kr, 16);
        const int pos = m & (SEQ - 1), i = F.lane & 15; const float cs = cosT[pos * 16 + i], sn = sinT[pos * 16 + i];
        const float ro = ((F.lane & 16) == 0) ? kr * cs - pr * sn : pr * sn + kr * cs;
        if (F.lane < 32) krope[(size_t)m * 32 + F.lane] = (bf16)f2bf(ro);
    }
}

struct Args { const float* in[24]; float* out; unsigned char* ws; int ph_lo, ph_hi; };
constexpr int LDS_BYTES = 147456, RING_BYTES = 131072, MISC_OFF = RING_BYTES + 320;

__global__ void __launch_bounds__(NWAVES * 64, 2) trunk_fwd(Args args) {
    extern __shared__ __attribute__((aligned(16))) unsigned char lds[];
    Frame F;
    F.lds = (LAS unsigned char*)lds; F.ws = args.ws; F.ctl = (gu32*)(args.ws + WS_CTL);
    F.tid = threadIdx.x; F.lane = F.tid & 63; F.wave = __builtin_amdgcn_readfirstlane(F.tid >> 6); F.G = gridDim.x;
    F.gw = blockIdx.x * NWAVES + F.wave; F.NGW = F.G * NWAVES;
    volatile LAS unsigned* MISC = (volatile LAS unsigned*)(F.lds + MISC_OFF);
    for (int u = F.tid; u < (LDS_BYTES - RING_BYTES) / 4; u += NWAVES * 64) ((LAS unsigned*)(F.lds + RING_BYTES))[u] = 0u;
    __syncthreads();
    const int lo = args.ph_lo, hi = args.ph_hi;
    XcdBarrier bar; bar.bar = (unsigned*)(F.ctl + CW_BAR); bar.x = 0; bar.st = nullptr;
    if (hi - lo > 1) bar = xcd_barrier_post((unsigned*)(F.ctl + CW_BAR), MISC + 8);
#define IN(k) (lo <= (k) && (k) < hi)
#define RUN(k) if (IN(k)) _Pragma("unroll") for (int rep_ = 0; rep_ < ((((k) == PROBE_A) || ((k) == PROBE_B) || ((k) == PROBE_C)) ? 2 : 1); ++rep_)
#define SEAM(k) do { if (IN(k) && IN((k) + 1)) xcd_barrier(bar); } while (0)
    const float* const* in = args.in;
    unsigned char* ws = args.ws;
    float* xres = args.out;
    unsigned char* WB = ws + WS_WSM; unsigned char* WM = ws + WS_WMOE;
    bf16* H = (bf16*)(ws + WS_H); signed char* H8 = (signed char*)(ws + WS_H);
    float* SA = (float*)(ws + WS_TAB + TAB_SA); float* SAP = (float*)(ws + WS_TAB + TAB_SAP); const float* SB = (const float*)(ws + WS_TAB + TAB_SB);
    unsigned char* scr = ws + WS_SCR; bf16* DELTA = (bf16*)(scr + SC_DELTA);
    const float* cosT = (const float*)(ws + WS_TAB + TAB_COS); const float* sinT = (const float*)(ws + WS_TAB + TAB_SIN);
    LAS unsigned char* ring = F.lds;
    const int c = (int)blockIdx.x;

#define GEMM_BF16S_I8(Btp, N_, Op, ldc_, biasp, nsc_, sc_, sbo_) do { pg8::Gemm g{(const pg8::bf16_t*)H8, (const pg8::bf16_t*)(Btp), T, (N_), D, D}; pg8::StaticOrder S; S.init(T, (N_), F.G, c); \
        pg8::EpiBf16S E{(pg8::bf16_t*)(Op), (ldc_), (biasp), (nsc_), (sc_), SA, SB + (sbo_)}; pg8::gemm_phase<pg8::EpiBf16S, pg8::StaticOrder, true, true, true>(ring, g, S, E); } while (0)
#define GEMM_BF16S(Ap, Btp, M_, N_, K_, Op, ldc_, nsc_, sc_) do { pg8::Gemm g{(const pg8::bf16_t*)(Ap), (const pg8::bf16_t*)(Btp), (M_), (N_), (K_), (K_)}; pg8::StaticOrder S; S.init((M_), (N_), F.G, c); \
        pg8::EpiBf16S E{(pg8::bf16_t*)(Op), (ldc_), nullptr, (nsc_), (sc_), nullptr, nullptr}; pg8::gemm_phase<pg8::EpiBf16S, pg8::StaticOrder, true, true, false>(ring, g, S, E); } while (0)
#define GEMM_RES(Ap, Btp, K_, basep) do { pg8::Gemm g{(const pg8::bf16_t*)(Ap), (const pg8::bf16_t*)(Btp), T, D, (K_), (K_)}; pg8::StaticOrder S; S.init(T, D, F.G, c); \
        pg8::EpiResF32 E{(basep), xres, D}; pg8::gemm_phase<pg8::EpiResF32, pg8::StaticOrder, true, true, false>(ring, g, S, E); } while (0)
#define GEMM_SWIGLU_I8(Btp, N2_, Op, sbo_) do { pg8::Gemm g{(const pg8::bf16_t*)H8, (const pg8::bf16_t*)(Btp), T, (N2_), D, D}; pg8::StaticOrder S; S.init(T, (N2_), F.G, c); \
        pg8::EpiSwiGLU E{(pg8::bf16_t*)(Op), (N2_) / 2, SA, SB + (sbo_)}; pg8::gemm_phase<pg8::EpiSwiGLU, pg8::StaticOrder, true, true, true>(ring, g, S, E); } while (0)
#define ATTN(MODE_, AA) do { if ((NAIVE_ATTN >> (MODE_)) & 1) att::attn_naive<MODE_>(AA, F.G, c); else att::attn_phase<MODE_>((LAS char*)ring, AA, F.G, c); } while (0)
#define MOE_GEMMS(layer_, k1, k2) \
    RUN(k1) { const MoeLayout ML = moe_layout(F, (layer_)); pg8::Gemm g{(const pg8::bf16_t*)(scr + SC_HPERM), (const pg8::bf16_t*)WM, PMAX, 2 * EDIM, D, D}; \
        pg8::GroupedOrder S; S.nM = ML.tp[8]; S.nN = 2 * EDIM / 256; S.nwg = S.nM * S.nN; S.G = F.G; S.c = c; S.tp1 = ML.tp[1]; S.tp2 = ML.tp[2]; S.tp3 = ML.tp[3]; S.tp4 = ML.tp[4]; S.tp5 = ML.tp[5]; S.tp6 = ML.tp[6]; S.tp7 = ML.tp[7]; S.estride = (long)B_MOEGU_E; S.sstride = 2 * EDIM; \
        pg8::EpiSwiGLU E{(pg8::bf16_t*)(scr + SC_MACT), EDIM, SAP, SB + SBO_MOE + (layer_) * 57344}; pg8::gemm_phase<pg8::EpiSwiGLU, pg8::GroupedOrder, true, true, true>(ring, g, S, E); } \
    SEAM(k1); \
    RUN(k2) { const MoeLayout ML = moe_layout(F, (layer_)); \
        { pg8::Gemm g{(const pg8::bf16_t*)(scr + SC_MACT), (const pg8::bf16_t*)(WM + B_MOED), PMAX, D, EDIM, EDIM}; \
          pg8::GroupedOrder S; S.nM = ML.tp[8] < 256 ? ML.tp[8] : 256; S.nN = D / 256; S.nwg = S.nM * S.nN; S.G = F.G; S.c = c; S.tp1 = ML.tp[1]; S.tp2 = ML.tp[2]; S.tp3 = ML.tp[3]; S.tp4 = ML.tp[4]; S.tp5 = ML.tp[5]; S.tp6 = ML.tp[6]; S.tp7 = ML.tp[7]; S.estride = (long)B_MOED_E; S.sstride = 0; \
          pg8::EpiBf16S E{(pg8::bf16_t*)(scr + SC_HPERM), D, nullptr, 0, 1.f, nullptr, nullptr}; pg8::gemm_phase<pg8::EpiBf16S, pg8::GroupedOrder, true, true, false>(ring, g, S, E); } \
        if (ML.tp[8] > 256) { pg8::Gemm g{(const pg8::bf16_t*)(scr + SC_MACT), (const pg8::bf16_t*)(WM + B_MOED), PMAX, D, 512, EDIM}; \
          pg8::SplitKOrder S; S.nrem = ML.tp[8] - 256; S.G = F.G; S.c = c; S.tp1 = ML.tp[1]; S.tp2 = ML.tp[2]; S.tp3 = ML.tp[3]; S.tp4 = ML.tp[4]; S.tp5 = ML.tp[5]; S.tp6 = ML.tp[6]; S.tp7 = ML.tp[7]; S.estride = (long)B_MOED_E; S.pstride = (long)YP_ELEMS; \
          pg8::EpiBf16S E{(pg8::bf16_t*)(ws + WS_YP), D, nullptr, 0, 1.f, nullptr, nullptr}; pg8::gemm_phase<pg8::EpiBf16S, pg8::SplitKOrder, true, true, false>(ring, g, S, E); } } \
    SEAM(k2);

    RUN(0) { quant_small(F, in); quant_moe_gu(F, in[21], in[22], 0); convert_small_bf16(F, in); convert_moe_down(F, in[23]); zero_mlad_pad(F); norm_phase(F, in[0], nullptr, nullptr, in[2], H8, SA); }
    SEAM(0);
    RUN(2) GEMM_BF16S_I8(WB + B_SWAQKV, SWA_N, scr + SC_QKV, SWA_N, in[6], 4, 0.125f * LOG2E, SBO_SWAQKV);
    SEAM(2);
    RUN(3) { const bf16* QKV = (const bf16*)(scr + SC_QKV); att::Args A{QKV, SWA_N, 64, QKV + 1024, SWA_N, 64, nullptr, QKV + 1152, SWA_N, 64, H, cosT, sinT, in[1], in[7]}; ATTN(0, A); }
    SEAM(3);
    RUN(4) GEMM_RES(H, WB + B_SWAO, D, in[0]);
    SEAM(4);
    RUN(5) norm_phase(F, xres, nullptr, nullptr, in[3], H8, SA);
    SEAM(5);
    RUN(6) GEMM_SWIGLU_I8(WB + B_FFNGU, 2 * FFN, scr + SC_ACT, SBO_FFNGU);
    SEAM(6);
    RUN(7) GEMM_RES(scr + SC_ACT, WB + B_FFND, FFN, xres);
    SEAM(7);
    RUN(8) norm_phase(F, xres, nullptr, nullptr, in[2] + D, H8, SA);
    SEAM(8);
    RUN(9) GEMM_BF16S_I8(WB + B_SBQKV, SB_N, scr + SC_QKV, SB_N, nullptr, 4, 0.125f * LOG2E, SBO_SBQKV);
    SEAM(9);
    RUN(10) { const bf16* QKV = (const bf16*)(scr + SC_QKV); att::Args A{QKV, SB_N, 64, QKV + 1024, SB_N, 64, nullptr, QKV + 2048, SB_N, 64, H, cosT, sinT, in[1], in[7]}; ATTN(1, A); }
    SEAM(10);
    RUN(11) GEMM_RES(H, WB + B_SBO, D, xres);
    SEAM(11);
    RUN(12) norm_route_phase(F, xres, nullptr, in[3] + D, H8, SA, in[20], 0);
    SEAM(12);
    RUN(13) route_assign_phase(F, H8, SA, (signed char*)(scr + SC_HPERM), SAP, 0);
    SEAM(13);
    MOE_GEMMS(0, 14, 15)
    RUN(16) { combine_norm_phase<false>(F, xres, (const bf16*)(scr + SC_HPERM), in[2] + 2 * D, H8, SA);
              quant_moe_gu(F, in[21] + (size_t)8 * D * EDIM, in[22] + (size_t)8 * D * EDIM, 1); convert_moe_down(F, in[23] + (size_t)8 * EDIM * D); }
    SEAM(16);
    RUN(17) GEMM_BF16S_I8(WB + B_MLAD, MLA_DN, scr + SC_C, MLA_DN, nullptr, 0, 1.f, SBO_MLAD);
    SEAM(17);
    RUN(18) mla_cnorm_phase(F, (const bf16*)(scr + SC_C), in[12], in[14], (bf16*)(scr + SC_CQN), (bf16*)(scr + SC_CKVN), (bf16*)(scr + SC_KROPE));
    SEAM(18);
    RUN(19) { GEMM_BF16S(scr + SC_CQN, WB + B_MLAUQ, T, MLA_UQN, MLA_QR, scr + SC_QM, MLA_UQN, 6, 0.10206207261596577f * LOG2E);
              GEMM_BF16S(scr + SC_CKVN, WB + B_MLAUKV, T, MLA_UKVN, MLA_KVR, scr + SC_KVM, MLA_UKVN, 0, 1.f); }
    SEAM(19);
    RUN(20) { const bf16* KV = (const bf16*)(scr + SC_KVM); att::Args A{(const bf16*)(scr + SC_QM), MLA_UQN, 96, KV, MLA_UKVN, 128, (const bf16*)(scr + SC_KROPE), KV + 64, MLA_UKVN, 128, H, cosT, sinT, in[1], in[7]}; ATTN(2, A); }
    SEAM(20);
    RUN(21) GEMM_RES(H, WB + B_MLAO, D, xres);
    SEAM(21);
    RUN(22) norm_phase(F, xres, nullptr, nullptr, in[3] + 2 * D, H8, SA);
    SEAM(22);
    RUN(23) GEMM_SWIGLU_I8(WB + B_FFNGU + (size_t)2 * FFN * D, 2 * FFN, scr + SC_ACT, SBO_FFNGU + 2 * FFN);
    SEAM(23);
    RUN(24) GEMM_RES(scr + SC_ACT, WB + B_FFND + (size_t)D * FFN * 2, FFN, xres);
    SEAM(24);
    RUN(25) norm_phase(F, xres, nullptr, nullptr, in[2] + 3 * D, H8, SA);
    SEAM(25);
    RUN(26) GEMM_BF16S_I8(WB + B_SWAQKV + (size_t)SWA_N * D, SWA_N, scr + SC_QKV, SWA_N, in[6] + SWA_N, 4, 0.125f * LOG2E, SBO_SWAQKV + SWA_N);
    SEAM(26);
    RUN(27) { const bf16* QKV = (const bf16*)(scr + SC_QKV); att::Args A{QKV, SWA_N, 64, QKV + 1024, SWA_N, 64, nullptr, QKV + 1152, SWA_N, 64, H, cosT, sinT, in[1], in[7] + 16}; ATTN(0, A); }
    SEAM(27);
    RUN(28) GEMM_RES(H, WB + B_SWAO + (size_t)D * D * 2, D, xres);
    SEAM(28);
    RUN(29) norm_route_phase(F, xres, nullptr, in[3] + 3 * D, H8, SA, in[20] + D * NEXP, 1);
    SEAM(29);
    RUN(30) route_assign_phase(F, H8, SA, (signed char*)(scr + SC_HPERM), SAP, 1);
    SEAM(30);
    MOE_GEMMS(1, 31, 32)
    RUN(33) combine_norm_phase<true>(F, xres, (const bf16*)(scr + SC_HPERM), in[4], nullptr, nullptr);
#undef IN
#undef RUN
#undef SEAM
}

extern "C" void kernel_launch(void* const* d_in, const int* in_sizes, int n_in, void* d_out, int out_size, void* d_ws, size_t ws_size, hipStream_t stream) {
    static int grid = 0;
    if (grid == 0) {
        if (n_in != 24 || in_sizes[0] != T * D || out_size != T * D || ws_size < WS_END) { fprintf(stderr, "kernel_launch: unexpected problem (n_in %d, in0 %d, out %d, ws %zu < %zu); nothing launched\n", n_in, n_in > 0 ? in_sizes[0] : -1, out_size, ws_size, (size_t)WS_END); grid = -1; return; }
        int dev = 0, cus = 0, per_cu = 0;
        if (hipGetDevice(&dev) != hipSuccess || hipDeviceGetAttribute(&cus, hipDeviceAttributeMultiprocessorCount, dev) != hipSuccess) { grid = -1; return; }
        if (hipFuncSetAttribute((const void*)trunk_fwd, hipFuncAttributeMaxDynamicSharedMemorySize, LDS_BYTES) != hipSuccess) { fprintf(stderr, "kernel_launch: hipFuncSetAttribute failed\n"); grid = -1; return; }
        if (hipOccupancyMaxActiveBlocksPerMultiprocessor(&per_cu, (const void*)trunk_fwd, NWAVES * 64, LDS_BYTES) != hipSuccess || per_cu < 1) { fprintf(stderr, "kernel_launch: occupancy query reports %d blocks per CU\n", per_cu); }
        (void)hipGetLastError();
        grid = cus;
    }
    if (grid < 0) return;
    if (hipMemsetAsync((char*)d_ws + WS_CTL, 0, CTL_ZERO_BYTES, stream) != hipSuccess) return;
    Args a{};
    for (int i = 0; i < 24; ++i) a.in[i] = (const float*)d_in[i];
    a.out = (float*)d_out; a.ws = (unsigned char*)d_ws;
#if MK_PER_PHASE
    for (int p = 0; p < NPH; ++p) { a.ph_lo = p; a.ph_hi = p + 1; hipLaunchKernelGGL(trunk_fwd, dim3(grid), dim3(NWAVES * 64), LDS_BYTES, stream, a); }
#else
    a.ph_lo = 0; a.ph_hi = NPH;
    hipLaunchKernelGGL(trunk_fwd, dim3(grid), dim3(NWAVES * 64), LDS_BYTES, stream, a);
#endif
    const hipError_t le = hipPeekAtLastError();
    if (le != hipSuccess) fprintf(stderr, "kernel_launch: launch failed: %s\n", hipGetErrorName(le));
}
```
